# Optimizing an MI355X kernel written in HIP

```python
import math
import jax, jax.numpy as jnp
from jax import lax
import numpy as np

D_MODEL = 1024
BATCH = 16
SEQ = 2048
DEPTH = 1

N_ATTN_HEADS = 8
HEAD_DIM = 64
ATTN_WIDTH = N_ATTN_HEADS * HEAD_DIM
N_CONV_GROUPS = 8
CONV_WIDTH = D_MODEL // 2
CONV_K = 3
D_FF = 2816
Q_BLOCK = 128
RMS_EPS = 1e-6
FFN_RESIDUAL_WEIGHT = 0.5
FORGET_BIAS_MEAN = 3.0

IN_SPLITS = (
    ATTN_WIDTH,
    ATTN_WIDTH,
    ATTN_WIDTH,
    N_ATTN_HEADS,
    CONV_WIDTH,
    CONV_WIDTH,
    CONV_WIDTH,
    D_MODEL,
    D_MODEL,
)
IN_COLS = sum(IN_SPLITS)

kernel_name = "fox_shortconv_gated_macaron_layer"


def rms_norm(x, g):
    xf = x.astype(jnp.float32)
    inv = lax.rsqrt(jnp.mean(xf * xf, axis=-1, keepdims=True) + RMS_EPS)
    return (xf * inv).astype(x.dtype) * g


def swiglu(x, w_gate, w_up, w_down):
    return (jax.nn.silu(x @ w_gate) * (x @ w_up)) @ w_down


def forgetting_attention(q, k, v, f_logits, b_forget):
    seq = q.shape[1]
    scale = 1.0 / math.sqrt(HEAD_DIM)
    log_f = jax.nn.log_sigmoid(f_logits.astype(jnp.float32) + b_forget.astype(jnp.float32))
    cum = jnp.transpose(jnp.cumsum(log_f, axis=1), (0, 2, 1))
    outs = []
    n_blocks = seq // Q_BLOCK
    for i in range(n_blocks):
        q0, q1 = i * Q_BLOCK, (i + 1) * Q_BLOCK
        kv_len = q1
        q_blk = q[:, q0:q1]
        k_pre = k[:, :kv_len]
        v_pre = v[:, :kv_len]
        s = jnp.einsum('bqhd,bkhd->bhqk', q_blk, k_pre).astype(jnp.float32) * scale
        s = s + cum[:, :, q0:q1, None] - cum[:, :, None, :kv_len]
        q_pos = jnp.arange(q0, q1)[:, None]
        k_pos = jnp.arange(kv_len)[None, :]
        s = jnp.where(q_pos >= k_pos, s, -jnp.inf)
        p = jax.nn.softmax(s, axis=-1).astype(v.dtype)
        outs.append(jnp.einsum('bhqk,bkhd->bqhd', p, v_pre))
    return jnp.concatenate(outs, axis=1)


def short_conv_mixer(xin, gate_b, gate_c, conv_w):
    seq = xin.shape[1]
    u = gate_c * xin
    up = jnp.pad(u, ((0, 0), (CONV_K - 1, 0), (0, 0)))
    conv = (conv_w[0] * up[:, 0:seq] + conv_w[1] * up[:, 1:seq + 1]
            + conv_w[2] * up[:, 2:seq + 2])
    return gate_b * conv


def setup_inputs(seed: int = 0) -> dict:
    key = jax.random.key(seed)
    ks = jax.random.split(key, 20)
    f32 = jnp.float32

    def lin(k, fan_in, fan_out):
        return jax.random.normal(k, (fan_in, fan_out), f32) * fan_in ** -0.5

    def gain(k, n):
        return jnp.ones((n,), f32) + 0.02 * jax.random.normal(k, (n,), f32)

    return {
        "x": jax.random.normal(ks[0], (BATCH, SEQ, D_MODEL), f32),
        "ffn1_norm": gain(ks[1], D_MODEL),
        "ffn1_gate": lin(ks[2], D_MODEL, D_FF),
        "ffn1_up": lin(ks[3], D_MODEL, D_FF),
        "ffn1_down": lin(ks[4], D_FF, D_MODEL),
        "mix_norm": gain(ks[5], D_MODEL),
        "w_in": lin(ks[6], D_MODEL, IN_COLS),
        "b_forget": FORGET_BIAS_MEAN + 0.5 * jax.random.normal(ks[7], (N_ATTN_HEADS,), f32),
        "conv_w": 0.5 * jax.random.normal(ks[8], (CONV_K, CONV_WIDTH), f32),
        "w_o_attn": lin(ks[9], ATTN_WIDTH, D_MODEL),
        "w_o_conv": lin(ks[10], CONV_WIDTH, D_MODEL),
        "w_out": lin(ks[11], D_MODEL, D_MODEL),
        "ffn2_norm": gain(ks[12], D_MODEL),
        "ffn2_gate": lin(ks[13], D_MODEL, D_FF),
        "ffn2_up": lin(ks[14], D_MODEL, D_FF),
        "ffn2_down": lin(ks[15], D_FF, D_MODEL),
        "final_norm": gain(ks[16], D_MODEL),
    }


def reference(x, ffn1_norm, ffn1_gate, ffn1_up, ffn1_down, mix_norm, w_in,
              b_forget, conv_w, w_o_attn, w_o_conv, w_out, ffn2_norm,
              ffn2_gate, ffn2_up, ffn2_down, final_norm):
    bsz, seq, _ = x.shape
    for _layer in range(DEPTH):
        x = x + FFN_RESIDUAL_WEIGHT * swiglu(rms_norm(x, ffn1_norm), ffn1_gate, ffn1_up, ffn1_down)

        h = rms_norm(x, mix_norm)
        proj = h @ w_in
        offsets = list(np.cumsum(IN_SPLITS)[:-1])
        q, k, v, f_log, c_b, c_c, c_x, g_attn, g_conv = jnp.split(proj, offsets, axis=-1)

        heads = lambda t: t.reshape(bsz, seq, N_ATTN_HEADS, HEAD_DIM)
        y_attn = forgetting_attention(heads(q), heads(k), heads(v), f_log, b_forget)
        y_attn = y_attn.reshape(bsz, seq, ATTN_WIDTH) @ w_o_attn

        y_conv = short_conv_mixer(c_x, c_b, c_c, conv_w) @ w_o_conv

        merged = jax.nn.sigmoid(g_attn) * y_attn + jax.nn.sigmoid(g_conv) * y_conv
        x = x + merged @ w_out

        x = x + FFN_RESIDUAL_WEIGHT * swiglu(rms_norm(x, ffn2_norm), ffn2_gate, ffn2_up, ffn2_down)
    return rms_norm(x, final_norm)
```

```cpp
#include <hip/hip_runtime.h>
#include <cstdio>
#include <cstdint>

typedef unsigned short bf16_t;
typedef short bf16x8 __attribute__((ext_vector_type(8)));
typedef float f32x4 __attribute__((ext_vector_type(4)));

constexpr int NB = 16, SEQ = 2048, DM = 1024, M = NB * SEQ;
constexpr int NH = 8, HD = 64, AW = NH * HD, CW = 512, FF = 2816, INC = 5128;
constexpr int NGU = 2 * FF;
constexpr int NWIN = 5120;
constexpr float RMS_EPS = 1e-6f;
constexpr float LOG2E = 1.4426950408889634f;
constexpr float C2 = 0.125f * LOG2E;
constexpr int CHUNK = 128, NCHUNK = SEQ / CHUNK;

constexpr int IC_Q = 0, IC_K = 512, IC_V = 1024, IC_F = 1536, IC_CB = 1544, IC_CC = 2056, IC_CX = 2568, IC_GA = 3080, IC_GC = 4104;

constexpr size_t MiB = 1u << 20;
constexpr size_t WS_CTL = 0;
constexpr size_t WS_SSQ = 1 * MiB;
constexpr size_t WS_LC = 3 * MiB;
constexpr size_t WS_TOT = 4 * MiB;
constexpr size_t WS_WF = 4 * MiB + 65536;
constexpr size_t WS_W1GU = 8 * MiB, WS_W1D = 19 * MiB + 512 * 1024, WS_WIN = 25 * MiB, WS_WOA = 35 * MiB, WS_WOC = 36 * MiB, WS_WOUT = 37 * MiB, WS_W2GU = 39 * MiB, WS_W2D = 50 * MiB + 512 * 1024;
constexpr size_t WS_XN = 64 * MiB;
constexpr size_t WS_Q = 128 * MiB, WS_K = 160 * MiB, WS_V = 192 * MiB, WS_U = 224 * MiB, WS_CB = 256 * MiB, WS_YCV = 288 * MiB;
constexpr size_t WS_H = 128 * MiB;
constexpr size_t WS_GA = 320 * MiB, WS_GC = 384 * MiB;
constexpr size_t WS_T = 160 * MiB;
constexpr size_t WS_END = 448 * MiB;

__device__ __forceinline__ unsigned f2bf(float f) { unsigned u = __builtin_bit_cast(unsigned, f); return (u + 0x7fffu + ((u >> 16) & 1u)) >> 16; }
__device__ __forceinline__ float bf2f(bf16_t h) { return __builtin_bit_cast(float, (unsigned)h << 16); }

__device__ __forceinline__ int win_row(int c) {
    if (c < IC_F) return c;
    if (c < IC_CB) return -1;
    if (c < IC_CC) return 2560 + (c - IC_CB);
    if (c < IC_CX) { const int j = c - IC_CC; return (6 + (j >> 7)) * 256 + (j & 127); }
    if (c < IC_GA) { const int j = c - IC_CX; return (6 + (j >> 7)) * 256 + 128 + (j & 127); }
    if (c < IC_GC) return 3072 + (c - IC_GA);
    return 4096 + (c - IC_GC);
}
__device__ __forceinline__ int gu_row(int j, int up) { return (j >> 7) * 256 + up * 128 + (j & 127); }

__global__ void nv_convert_w(const float* W, bf16_t* Bt, const float* gain, float* WF, int K, int N, int mode, int pad_) {
    const long i = (long)blockIdx.x * blockDim.x + threadIdx.x;
    if (i >= (long)K * N) return;
    const int k = (int)(i / N), n = (int)(i % N);
    float v = W[i]; if (gain) v *= gain[k];
    int row = n;
    if (mode == 1) row = gu_row(n, 0); else if (mode == 2) row = gu_row(n, 1); else if (mode == 3) row = win_row(n);
    if (row < 0) { WF[(n - IC_F) * K + k] = v; return; }
    Bt[(size_t)row * K + k] = (bf16_t)f2bf(v);
}
__global__ void nv_x_to_xn(const float* x, bf16_t* XN, float* SSQ) {
    const int row = blockIdx.x * 4 + (threadIdx.x >> 6), lane = threadIdx.x & 63;
    float s = 0.f;
    for (int c = lane; c < DM; c += 64) { const float v = x[(size_t)row * DM + c]; s += v * v; XN[(size_t)row * DM + c] = (bf16_t)f2bf(v); }
    for (int o = 1; o < 64; o <<= 1) s += __shfl_xor(s, o);
    if (lane < 16) SSQ[(size_t)row * 16 + lane] = lane == 0 ? s : 0.f;
}
__device__ __forceinline__ float row_rstd(const float* SSQ, int row) {
    float s = 0.f;
    for (int i = 0; i < 16; ++i) s += SSQ[(size_t)row * 16 + i];
    return 1.0f / sqrtf(s * (1.0f / DM) + RMS_EPS);
}
struct NvSwiglu { static constexpr bool PAIR = true; bf16_t* H;
    __device__ void operator()(int r, int c, float g, float u, float rs) const { g *= rs; u *= rs; const float h = g / (1.0f + __expf(-g)) * u; H[(size_t)r * FF + (c >> 8) * 128 + (c & 127)] = (bf16_t)f2bf(h); } };
struct NvResid { static constexpr bool PAIR = false; const float* xin; float* xout; bf16_t* XN; float alpha; int pad;
    __device__ void operator()(int r, int c, float v, float, float) const { const float xn = xin[(size_t)r * DM + c] + alpha * v; xout[(size_t)r * DM + c] = xn; XN[(size_t)r * DM + c] = (bf16_t)f2bf(xn); } };
struct NvWin { static constexpr bool PAIR = false; bf16_t *Q, *K, *V, *U, *CB, *GA, *GC;
    __device__ void operator()(int r, int c, float v, float v2, float rs) const {
        const int t = c >> 8; v *= rs;
        if (t < 2) Q[(size_t)r * AW + c] = (bf16_t)f2bf(v * C2);
        else if (t < 4) K[(size_t)r * AW + (c - 512)] = (bf16_t)f2bf(v);
        else if (t < 6) V[(size_t)r * AW + (c - 1024)] = (bf16_t)f2bf(v);
        else if (t < 10) { if ((c & 255) < 128) U[(size_t)r * CW + (t - 6) * 128 + (c & 127)] = (bf16_t)f2bf(v * (v2 * rs)); }
        else if (t < 12) CB[(size_t)r * CW + (c - 2560)] = (bf16_t)f2bf(v);
        else if (t < 16) GA[(size_t)r * DM + (c - 3072)] = (bf16_t)f2bf(1.0f / (1.0f + __expf(-v)));
        else GC[(size_t)r * DM + (c - 4096)] = (bf16_t)f2bf(1.0f / (1.0f + __expf(-v)));
    } };
struct NvGateA { static constexpr bool PAIR = false; const bf16_t* GA; bf16_t* T;
    __device__ void operator()(int r, int c, float v, float, float) const { T[(size_t)r * DM + c] = (bf16_t)f2bf(bf2f(GA[(size_t)r * DM + c]) * v); } };
struct NvGateC { static constexpr bool PAIR = false; const bf16_t* GC; bf16_t* T;
    __device__ void operator()(int r, int c, float v, float, float) const { T[(size_t)r * DM + c] = (bf16_t)f2bf(bf2f(T[(size_t)r * DM + c]) + bf2f(GC[(size_t)r * DM + c]) * v); } };

template <class Epi> __global__ __launch_bounds__(256) void nv_gemm(const bf16_t* A, const bf16_t* Bt, const float* SSQ, int N, int K, int pairmode, int pad_, Epi epi) {
    const int wid = threadIdx.x >> 6, l = threadIdx.x & 63, wr = wid >> 1, wc = wid & 1;
    const int r0 = blockIdx.y * 64 + wr * 32;
    int c0;
    if (pairmode == 1) c0 = (blockIdx.x >> 1) * 256 + (blockIdx.x & 1) * 64 + wc * 32; else c0 = blockIdx.x * 64 + wc * 32;
    const bool pair = pairmode == 1 || (pairmode == 2 && (c0 >> 8) >= 6 && (c0 >> 8) < 10 && (c0 & 255) < 128);
    f32x4 acc[2][2], accp[2][2];
    for (int i = 0; i < 2; ++i) for (int j = 0; j < 2; ++j) { acc[i][j] = (f32x4){0.f, 0.f, 0.f, 0.f}; accp[i][j] = (f32x4){0.f, 0.f, 0.f, 0.f}; }
    const bf16_t* ap = A + (size_t)(r0 + (l & 15)) * K + 8 * (l >> 4);
    const bf16_t* bp = Bt + (size_t)(c0 + (l & 15)) * K + 8 * (l >> 4);
    for (int k0 = 0; k0 < K; k0 += 32) {
        bf16x8 a[2], b[2];
        for (int i = 0; i < 2; ++i) a[i] = *(const bf16x8*)(ap + (size_t)i * 16 * K + k0);
        for (int j = 0; j < 2; ++j) b[j] = *(const bf16x8*)(bp + (size_t)j * 16 * K + k0);
        for (int i = 0; i < 2; ++i) for (int j = 0; j < 2; ++j) acc[i][j] = __builtin_amdgcn_mfma_f32_16x16x32_bf16(a[i], b[j], acc[i][j], 0, 0, 0);
        if (pair) {
            for (int j = 0; j < 2; ++j) b[j] = *(const bf16x8*)(bp + (size_t)(128 + j * 16) * K + k0);
            for (int i = 0; i < 2; ++i) for (int j = 0; j < 2; ++j) accp[i][j] = __builtin_amdgcn_mfma_f32_16x16x32_bf16(a[i], b[j], accp[i][j], 0, 0, 0);
        }
    }
    for (int i = 0; i < 2; ++i)
        for (int reg = 0; reg < 4; ++reg) {
            const int r = r0 + 16 * i + (l >> 4) * 4 + reg;
            const float rs = SSQ ? row_rstd(SSQ, r) : 1.0f;
            for (int j = 0; j < 2; ++j) epi(r, c0 + 16 * j + (l & 15), acc[i][j][reg], accp[i][j][reg], rs);
        }
}
__global__ void nv_rowstats(const float* X, float* SSQ) {
    const int row = blockIdx.x * 4 + (threadIdx.x >> 6), lane = threadIdx.x & 63;
    float s = 0.f;
    for (int c = lane; c < DM; c += 64) { const float v = X[(size_t)row * DM + c]; s += v * v; }
    for (int o = 1; o < 64; o <<= 1) s += __shfl_xor(s, o);
    if (lane < 16) SSQ[(size_t)row * 16 + lane] = lane == 0 ? s : 0.f;
}
__global__ void nv_flogit(const bf16_t* XN, const float* WF, const float* SSQ, const float* bfg, float* LC) {
    const int row = blockIdx.x * 4 + (threadIdx.x >> 6), lane = threadIdx.x & 63;
    float acc[NH];
    for (int h = 0; h < NH; ++h) acc[h] = 0.f;
    for (int c = lane; c < DM; c += 64) { const float v = bf2f(XN[(size_t)row * DM + c]); for (int h = 0; h < NH; ++h) acc[h] += v * WF[h * DM + c]; }
    for (int h = 0; h < NH; ++h) for (int o = 1; o < 64; o <<= 1) acc[h] += __shfl_xor(acc[h], o);
    if (lane < NH) {
        float a = 0.f;
        for (int h = 0; h < NH; ++h) if (h == lane) a = acc[h];
        const float z = a * row_rstd(SSQ, row) + bfg[lane];
        const float ls = fminf(z, 0.f) - log1pf(__expf(-fabsf(z)));
        const int b = row / SEQ, t = row % SEQ;
        LC[((size_t)b * NH + lane) * SEQ + t] = ls * LOG2E;
    }
}
__global__ void nv_scan(float* LC, float* TOT) {
    const int i = blockIdx.x * blockDim.x + threadIdx.x;
    if (i >= NB * NH * NCHUNK) return;
    const int ch = i % NCHUNK, bh = i / NCHUNK, b = bh / NH, h = bh % NH;
    float* p = LC + (size_t)bh * SEQ + ch * CHUNK; float s = 0.f;
    for (int t = 0; t < CHUNK; ++t) { s += p[t]; p[t] = s; }
    TOT[((size_t)b * NCHUNK + ch) * NH + h] = s;
}
__device__ __forceinline__ float cum_at(const float* LC, const float* TOT, int b, int h, int t) {
    float s = LC[((size_t)b * NH + h) * SEQ + t];
    const int ch = t / CHUNK;
    for (int c = 0; c < ch; ++c) s += TOT[((size_t)b * NCHUNK + c) * NH + h];
    return s;
}
__global__ __launch_bounds__(64) void nv_attn(const bf16_t* Q, const bf16_t* K, const bf16_t* V, bf16_t* O, const float* LC, const float* TOT) {
    const int q = blockIdx.x % SEQ, h = (blockIdx.x / SEQ) % NH, b = blockIdx.x / (SEQ * NH), lane = threadIdx.x;
    const size_t rowq = (size_t)b * SEQ + q;
    float qv[HD];
    _Pragma("unroll") for (int d = 0; d < HD; ++d) qv[d] = bf2f(Q[rowq * AW + h * HD + d]);
    const float cq = cum_at(LC, TOT, b, h, q);
    float m = -INFINITY, lsum = 0.f, o[HD];
    for (int d = 0; d < HD; ++d) o[d] = 0.f;
    for (int k = lane; k <= q; k += 64) {
        const size_t rowk = (size_t)b * SEQ + k;
        float s = 0.f;
        for (int d = 0; d < HD; ++d) s += qv[d] * bf2f(K[rowk * AW + h * HD + d]);
        s += cq - cum_at(LC, TOT, b, h, k);
        const float mn = fmaxf(m, s), f = exp2f(m - mn), p = exp2f(s - mn);
        lsum = lsum * f + p;
        for (int d = 0; d < HD; ++d) o[d] = o[d] * f + p * bf2f(V[rowk * AW + h * HD + d]);
        m = mn;
    }
    float mg = m;
    for (int off = 1; off < 64; off <<= 1) mg = fmaxf(mg, __shfl_xor(mg, off));
    const float f = (m == -INFINITY) ? 0.f : exp2f(m - mg);
    lsum *= f;
    for (int off = 1; off < 64; off <<= 1) lsum += __shfl_xor(lsum, off);
    for (int d = 0; d < HD; ++d) { float v = o[d] * f; for (int off = 1; off < 64; off <<= 1) v += __shfl_xor(v, off); o[d] = v; }
    if (lane == 0) for (int d = 0; d < HD; ++d) O[rowq * AW + h * HD + d] = (bf16_t)f2bf(o[d] / lsum);
}
__global__ void nv_conv(const bf16_t* U, const bf16_t* CB, const float* cw, bf16_t* Y) {
    const long i = (long)blockIdx.x * blockDim.x + threadIdx.x;
    if (i >= (long)M * CW) return;
    const int c = (int)(i % CW); const long row = i / CW; const int t = (int)(row % SEQ);
    const float u2 = bf2f(U[i]), u1 = t >= 1 ? bf2f(U[i - CW]) : 0.f, u0 = t >= 2 ? bf2f(U[i - 2 * CW]) : 0.f;
    Y[i] = (bf16_t)f2bf(bf2f(CB[i]) * (cw[c] * u0 + cw[CW + c] * u1 + cw[2 * CW + c] * u2));
}
__global__ void nv_final(const float* X, const float* SSQ, const float* g, float* out) {
    const int row = blockIdx.x * 4 + (threadIdx.x >> 6), lane = threadIdx.x & 63;
    const float rs = row_rstd(SSQ, row);
    for (int c = lane; c < DM; c += 64) out[(size_t)row * DM + c] = X[(size_t)row * DM + c] * rs * g[c];
}

extern "C" void kernel_launch(void* const* d_in, const int* in_sizes, int n_in, void* d_out, int out_size, void* d_ws, size_t ws_size, hipStream_t stream) {
    if (n_in != 17 || in_sizes[0] != M * DM || out_size != M * DM || ws_size < WS_END) { fprintf(stderr, "kernel_launch: unexpected shapes (n_in %d in0 %d out %d ws %zu)\n", n_in, n_in > 0 ? in_sizes[0] : -1, out_size, ws_size); return; }
    const float* x = (const float*)d_in[0];
    const float *n1 = (const float*)d_in[1], *w1g = (const float*)d_in[2], *w1u = (const float*)d_in[3], *w1d = (const float*)d_in[4], *nm = (const float*)d_in[5], *win = (const float*)d_in[6];
    const float *bfg = (const float*)d_in[7], *cw = (const float*)d_in[8], *woa = (const float*)d_in[9], *woc = (const float*)d_in[10], *wout = (const float*)d_in[11];
    const float *n2 = (const float*)d_in[12], *w2g = (const float*)d_in[13], *w2u = (const float*)d_in[14], *w2d = (const float*)d_in[15], *nf = (const float*)d_in[16];
    float* out = (float*)d_out; unsigned char* ws = (unsigned char*)d_ws;
    float* SSQ = (float*)(ws + WS_SSQ); float* LC = (float*)(ws + WS_LC); float* TOT = (float*)(ws + WS_TOT); float* WF = (float*)(ws + WS_WF);
    bf16_t *W1GU = (bf16_t*)(ws + WS_W1GU), *W1D = (bf16_t*)(ws + WS_W1D), *WIN = (bf16_t*)(ws + WS_WIN), *WOA = (bf16_t*)(ws + WS_WOA), *WOC = (bf16_t*)(ws + WS_WOC), *WOUT = (bf16_t*)(ws + WS_WOUT), *W2GU = (bf16_t*)(ws + WS_W2GU), *W2D = (bf16_t*)(ws + WS_W2D);
    bf16_t *XN = (bf16_t*)(ws + WS_XN), *Q = (bf16_t*)(ws + WS_Q), *Kb = (bf16_t*)(ws + WS_K), *Vb = (bf16_t*)(ws + WS_V), *U = (bf16_t*)(ws + WS_U), *CB = (bf16_t*)(ws + WS_CB), *YCV = (bf16_t*)(ws + WS_YCV);
    bf16_t *H = (bf16_t*)(ws + WS_H), *GA = (bf16_t*)(ws + WS_GA), *GC = (bf16_t*)(ws + WS_GC), *T = (bf16_t*)(ws + WS_T);
    auto cvt = [&](const float* W, int K, int N, bf16_t* Bt, const float* gain, int mode) { const long n = (long)K * N; nv_convert_w<<<(unsigned)((n + 255) / 256), 256, 0, stream>>>(W, Bt, gain, WF, K, N, mode, 0); };
    cvt(w1g, DM, FF, W1GU, n1, 1); cvt(w1u, DM, FF, W1GU, n1, 2); cvt(w1d, FF, DM, W1D, nullptr, 0);
    cvt(win, DM, INC, WIN, nm, 3); cvt(woa, AW, DM, WOA, nullptr, 0); cvt(woc, CW, DM, WOC, nullptr, 0); cvt(wout, DM, DM, WOUT, nullptr, 0);
    cvt(w2g, DM, FF, W2GU, n2, 1); cvt(w2u, DM, FF, W2GU, n2, 2); cvt(w2d, FF, DM, W2D, nullptr, 0);
    nv_x_to_xn<<<M / 4, 256, 0, stream>>>(x, XN, SSQ);
    nv_gemm<NvSwiglu><<<dim3(NGU / 128, M / 64), 256, 0, stream>>>(XN, W1GU, SSQ, NGU, DM, 1, 0, NvSwiglu{H});
    nv_gemm<NvResid><<<dim3(DM / 64, M / 64), 256, 0, stream>>>(H, W1D, nullptr, DM, FF, 0, 0, NvResid{x, out, XN, 0.5f, 0});
    nv_rowstats<<<M / 4, 256, 0, stream>>>(out, SSQ);
    nv_flogit<<<M / 4, 256, 0, stream>>>(XN, WF, SSQ, bfg, LC);
    nv_scan<<<(NB * NH * NCHUNK + 255) / 256, 256, 0, stream>>>(LC, TOT);
    nv_gemm<NvWin><<<dim3(NWIN / 64, M / 64), 256, 0, stream>>>(XN, WIN, SSQ, NWIN, DM, 2, 0, NvWin{Q, Kb, Vb, U, CB, GA, GC});
    nv_attn<<<NB * NH * SEQ, 64, 0, stream>>>(Q, Kb, Vb, Q, LC, TOT);
    nv_conv<<<(unsigned)(((long)M * CW + 255) / 256), 256, 0, stream>>>(U, CB, cw, YCV);
    nv_gemm<NvGateA><<<dim3(DM / 64, M / 64), 256, 0, stream>>>(Q, WOA, nullptr, DM, AW, 0, 0, NvGateA{GA, T});
    nv_gemm<NvGateC><<<dim3(DM / 64, M / 64), 256, 0, stream>>>(YCV, WOC, nullptr, DM, CW, 0, 0, NvGateC{GC, T});
    nv_gemm<NvResid><<<dim3(DM / 64, M / 64), 256, 0, stream>>>(T, WOUT, nullptr, DM, DM, 0, 0, NvResid{out, out, XN, 1.0f, 0});
    nv_rowstats<<<M / 4, 256, 0, stream>>>(out, SSQ);
    nv_gemm<NvSwiglu><<<dim3(NGU / 128, M / 64), 256, 0, stream>>>(XN, W2GU, SSQ, NGU, DM, 1, 0, NvSwiglu{H});
    nv_gemm<NvResid><<<dim3(DM / 64, M / 64), 256, 0, stream>>>(H, W2D, nullptr, DM, FF, 0, 0, NvResid{out, out, XN, 0.5f, 0});
    nv_rowstats<<<M / 4, 256, 0, stream>>>(out, SSQ);
    nv_final<<<M / 4, 256, 0, stream>>>(out, SSQ, nf, out);
}
```

```cpp
#include <hip/hip_runtime.h>
#include <cstdio>
#include <cstdint>

typedef unsigned short bf16_t;
typedef short bf16x8 __attribute__((ext_vector_type(8)));
typedef float f32x4 __attribute__((ext_vector_type(4)));

constexpr int NB = 16, SEQ = 2048, DM = 1024, M = NB * SEQ;
constexpr int NH = 8, HD = 64, AW = NH * HD, CW = 512, FF = 2816, INC = 5128;
constexpr int NGU = 2 * FF;
constexpr int NWIN = 5120;
constexpr float RMS_EPS = 1e-6f;
constexpr float LOG2E = 1.4426950408889634f;
constexpr float C2 = 0.125f * LOG2E;
constexpr int CHUNK = 128, NCHUNK = SEQ / CHUNK;

constexpr int IC_Q = 0, IC_K = 512, IC_V = 1024, IC_F = 1536, IC_CB = 1544, IC_CC = 2056, IC_CX = 2568, IC_GA = 3080, IC_GC = 4104;

constexpr size_t MiB = 1u << 20;
constexpr size_t WS_CTL = 0;
constexpr size_t WS_SSQ = 1 * MiB;
constexpr size_t WS_LC = 3 * MiB;
constexpr size_t WS_TOT = 4 * MiB;
constexpr size_t WS_WF = 4 * MiB + 65536;
constexpr size_t WS_W1GU = 8 * MiB, WS_W1D = 19 * MiB + 512 * 1024, WS_WIN = 25 * MiB, WS_WOA = 35 * MiB, WS_WOC = 36 * MiB, WS_WOUT = 37 * MiB, WS_W2GU = 39 * MiB, WS_W2D = 50 * MiB + 512 * 1024;
constexpr size_t WS_XN = 64 * MiB;
constexpr size_t WS_Q = 128 * MiB, WS_K = 160 * MiB, WS_V = 192 * MiB, WS_U = 224 * MiB, WS_CB = 256 * MiB, WS_YCV = 288 * MiB;
constexpr size_t WS_H = 128 * MiB;
constexpr size_t WS_GA = 320 * MiB, WS_GC = 384 * MiB;
constexpr size_t WS_T = 160 * MiB;
constexpr size_t WS_END = 448 * MiB;

__device__ __forceinline__ unsigned f2bf(float f) { unsigned u = __builtin_bit_cast(unsigned, f); return (u + 0x7fffu + ((u >> 16) & 1u)) >> 16; }
__device__ __forceinline__ float bf2f(bf16_t h) { return __builtin_bit_cast(float, (unsigned)h << 16); }

__device__ __forceinline__ int win_row(int c) {
    if (c < IC_F) return c;
    if (c < IC_CB) return -1;
    if (c < IC_CC) return 2560 + (c - IC_CB);
    if (c < IC_CX) { const int j = c - IC_CC; return (6 + (j >> 7)) * 256 + (j & 127); }
    if (c < IC_GA) { const int j = c - IC_CX; return (6 + (j >> 7)) * 256 + 128 + (j & 127); }
    if (c < IC_GC) return 3072 + (c - IC_GA);
    return 4096 + (c - IC_GC);
}
__device__ __forceinline__ int gu_row(int j, int up) { return (j >> 7) * 256 + up * 128 + (j & 127); }

__global__ void nv_convert_w(const float* W, bf16_t* Bt, const float* gain, float* WF, int K, int N, int mode, int pad_) {
    const long i = (long)blockIdx.x * blockDim.x + threadIdx.x;
    if (i >= (long)K * N) return;
    const int k = (int)(i / N), n = (int)(i % N);
    float v = W[i]; if (gain) v *= gain[k];
    int row = n;
    if (mode == 1) row = gu_row(n, 0); else if (mode == 2) row = gu_row(n, 1); else if (mode == 3) row = win_row(n);
    if (row < 0) { WF[(n - IC_F) * K + k] = v; return; }
    Bt[(size_t)row * K + k] = (bf16_t)f2bf(v);
}
__global__ void nv_x_to_xn(const float* x, bf16_t* XN, float* SSQ) {
    const int row = blockIdx.x * 4 + (threadIdx.x >> 6), lane = threadIdx.x & 63;
    float s = 0.f;
    for (int c = lane; c < DM; c += 64) { const float v = x[(size_t)row * DM + c]; s += v * v; XN[(size_t)row * DM + c] = (bf16_t)f2bf(v); }
    for (int o = 1; o < 64; o <<= 1) s += __shfl_xor(s, o);
    if (lane < 16) SSQ[(size_t)row * 16 + lane] = lane == 0 ? s : 0.f;
}
__device__ __forceinline__ float row_rstd(const float* SSQ, int row) {
    float s = 0.f;
    for (int i = 0; i < 16; ++i) s += SSQ[(size_t)row * 16 + i];
    return 1.0f / sqrtf(s * (1.0f / DM) + RMS_EPS);
}
struct NvSwiglu { static constexpr bool PAIR = true; bf16_t* H;
    __device__ void operator()(int r, int c, float g, float u, float rs) const { g *= rs; u *= rs; const float h = g / (1.0f + __expf(-g)) * u; H[(size_t)r * FF + (c >> 8) * 128 + (c & 127)] = (bf16_t)f2bf(h); } };
struct NvResid { static constexpr bool PAIR = false; const float* xin; float* xout; bf16_t* XN; float alpha; int pad;
    __device__ void operator()(int r, int c, float v, float, float) const { const float xn = xin[(size_t)r * DM + c] + alpha * v; xout[(size_t)r * DM + c] = xn; XN[(size_t)r * DM + c] = (bf16_t)f2bf(xn); } };
struct NvWin { static constexpr bool PAIR = false; bf16_t *Q, *K, *V, *U, *CB, *GA, *GC;
    __device__ void operator()(int r, int c, float v, float v2, float rs) const {
        const int t = c >> 8; v *= rs;
        if (t < 2) Q[(size_t)r * AW + c] = (bf16_t)f2bf(v * C2);
        else if (t < 4) K[(size_t)r * AW + (c - 512)] = (bf16_t)f2bf(v);
        else if (t < 6) V[(size_t)r * AW + (c - 1024)] = (bf16_t)f2bf(v);
        else if (t < 10) { if ((c & 255) < 128) U[(size_t)r * CW + (t - 6) * 128 + (c & 127)] = (bf16_t)f2bf(v * (v2 * rs)); }
        else if (t < 12) CB[(size_t)r * CW + (c - 2560)] = (bf16_t)f2bf(v);
        else if (t < 16) GA[(size_t)r * DM + (c - 3072)] = (bf16_t)f2bf(1.0f / (1.0f + __expf(-v)));
        else GC[(size_t)r * DM + (c - 4096)] = (bf16_t)f2bf(1.0f / (1.0f + __expf(-v)));
    } };
struct NvGateA { static constexpr bool PAIR = false; const bf16_t* GA; bf16_t* T;
    __device__ void operator()(int r, int c, float v, float, float) const { T[(size_t)r * DM + c] = (bf16_t)f2bf(bf2f(GA[(size_t)r * DM + c]) * v); } };
struct NvGateC { static constexpr bool PAIR = false; const bf16_t* GC; bf16_t* T;
    __device__ void operator()(int r, int c, float v, float, float) const { T[(size_t)r * DM + c] = (bf16_t)f2bf(bf2f(T[(size_t)r * DM + c]) + bf2f(GC[(size_t)r * DM + c]) * v); } };

template <class Epi> __global__ __launch_bounds__(256) void nv_gemm(const bf16_t* A, const bf16_t* Bt, const float* SSQ, int N, int K, int pairmode, int pad_, Epi epi) {
    const int wid = threadIdx.x >> 6, l = threadIdx.x & 63, wr = wid >> 1, wc = wid & 1;
    const int r0 = blockIdx.y * 64 + wr * 32;
    int c0;
    if (pairmode == 1) c0 = (blockIdx.x >> 1) * 256 + (blockIdx.x & 1) * 64 + wc * 32; else c0 = blockIdx.x * 64 + wc * 32;
    const bool pair = pairmode == 1 || (pairmode == 2 && (c0 >> 8) >= 6 && (c0 >> 8) < 10 && (c0 & 255) < 128);
    f32x4 acc[2][2], accp[2][2];
    for (int i = 0; i < 2; ++i) for (int j = 0; j < 2; ++j) { acc[i][j] = (f32x4){0.f, 0.f, 0.f, 0.f}; accp[i][j] = (f32x4){0.f, 0.f, 0.f, 0.f}; }
    const bf16_t* ap = A + (size_t)(r0 + (l & 15)) * K + 8 * (l >> 4);
    const bf16_t* bp = Bt + (size_t)(c0 + (l & 15)) * K + 8 * (l >> 4);
    for (int k0 = 0; k0 < K; k0 += 32) {
        bf16x8 a[2], b[2];
        for (int i = 0; i < 2; ++i) a[i] = *(const bf16x8*)(ap + (size_t)i * 16 * K + k0);
        for (int j = 0; j < 2; ++j) b[j] = *(const bf16x8*)(bp + (size_t)j * 16 * K + k0);
        for (int i = 0; i < 2; ++i) for (int j = 0; j < 2; ++j) acc[i][j] = __builtin_amdgcn_mfma_f32_16x16x32_bf16(a[i], b[j], acc[i][j], 0, 0, 0);
        if (pair) {
            for (int j = 0; j < 2; ++j) b[j] = *(const bf16x8*)(bp + (size_t)(128 + j * 16) * K + k0);
            for (int i = 0; i < 2; ++i) for (int j = 0; j < 2; ++j) accp[i][j] = __builtin_amdgcn_mfma_f32_16x16x32_bf16(a[i], b[j], accp[i][j], 0, 0, 0);
        }
    }
    for (int i = 0; i < 2; ++i)
        for (int reg = 0; reg < 4; ++reg) {
            const int r = r0 + 16 * i + (l >> 4) * 4 + reg;
            const float rs = SSQ ? row_rstd(SSQ, r) : 1.0f;
            for (int j = 0; j < 2; ++j) epi(r, c0 + 16 * j + (l & 15), acc[i][j][reg], accp[i][j][reg], rs);
        }
}
__global__ void nv_rowstats(const float* X, float* SSQ) {
    const int row = blockIdx.x * 4 + (threadIdx.x >> 6), lane = threadIdx.x & 63;
    float s = 0.f;
    for (int c = lane; c < DM; c += 64) { const float v = X[(size_t)row * DM + c]; s += v * v; }
    for (int o = 1; o < 64; o <<= 1) s += __shfl_xor(s, o);
    if (lane < 16) SSQ[(size_t)row * 16 + lane] = lane == 0 ? s : 0.f;
}
__global__ void nv_flogit(const bf16_t* XN, const float* WF, const float* SSQ, const float* bfg, float* LC) {
    const int row = blockIdx.x * 4 + (threadIdx.x >> 6), lane = threadIdx.x & 63;
    float acc[NH];
    for (int h = 0; h < NH; ++h) acc[h] = 0.f;
    for (int c = lane; c < DM; c += 64) { const float v = bf2f(XN[(size_t)row * DM + c]); for (int h = 0; h < NH; ++h) acc[h] += v * WF[h * DM + c]; }
    for (int h = 0; h < NH; ++h) for (int o = 1; o < 64; o <<= 1) acc[h] += __shfl_xor(acc[h], o);
    if (lane < NH) {
        float a = 0.f;
        for (int h = 0; h < NH; ++h) if (h == lane) a = acc[h];
        const float z = a * row_rstd(SSQ, row) + bfg[lane];
        const float ls = fminf(z, 0.f) - log1pf(__expf(-fabsf(z)));
        const int b = row / SEQ, t = row % SEQ;
        LC[((size_t)b * NH + lane) * SEQ + t] = ls * LOG2E;
    }
}
__global__ void nv_scan(float* LC, float* TOT) {
    const int i = blockIdx.x * blockDim.x + threadIdx.x;
    if (i >= NB * NH * NCHUNK) return;
    const int ch = i % NCHUNK, bh = i / NCHUNK, b = bh / NH, h = bh % NH;
    float* p = LC + (size_t)bh * SEQ + ch * CHUNK; float s = 0.f;
    for (int t = 0; t < CHUNK; ++t) { s += p[t]; p[t] = s; }
    TOT[((size_t)b * NCHUNK + ch) * NH + h] = s;
}
__device__ __forceinline__ float cum_at(const float* LC, const float* TOT, int b, int h, int t) {
    float s = LC[((size_t)b * NH + h) * SEQ + t];
    const int ch = t / CHUNK;
    for (int c = 0; c < ch; ++c) s += TOT[((size_t)b * NCHUNK + c) * NH + h];
    return s;
}
__global__ __launch_bounds__(64) void nv_attn(const bf16_t* Q, const bf16_t* K, const bf16_t* V, bf16_t* O, const float* LC, const float* TOT) {
    const int q = blockIdx.x % SEQ, h = (blockIdx.x / SEQ) % NH, b = blockIdx.x / (SEQ * NH), lane = threadIdx.x;
    const size_t rowq = (size_t)b * SEQ + q;
    float qv[HD];
    _Pragma("unroll") for (int d = 0; d < HD; ++d) qv[d] = bf2f(Q[rowq * AW + h * HD + d]);
    const float cq = cum_at(LC, TOT, b, h, q);
    float m = -INFINITY, lsum = 0.f, o[HD];
    for (int d = 0; d < HD; ++d) o[d] = 0.f;
    for (int k = lane; k <= q; k += 64) {
        const size_t rowk = (size_t)b * SEQ + k;
        float s = 0.f;
        for (int d = 0; d < HD; ++d) s += qv[d] * bf2f(K[rowk * AW + h * HD + d]);
        s += cq - cum_at(LC, TOT, b, h, k);
        const float mn = fmaxf(m, s), f = exp2f(m - mn), p = exp2f(s - mn);
        lsum = lsum * f + p;
        for (int d = 0; d < HD; ++d) o[d] = o[d] * f + p * bf2f(V[rowk * AW + h * HD + d]);
        m = mn;
    }
    float mg = m;
    for (int off = 1; off < 64; off <<= 1) mg = fmaxf(mg, __shfl_xor(mg, off));
    const float f = (m == -INFINITY) ? 0.f : exp2f(m - mg);
    lsum *= f;
    for (int off = 1; off < 64; off <<= 1) lsum += __shfl_xor(lsum, off);
    for (int d = 0; d < HD; ++d) { float v = o[d] * f; for (int off = 1; off < 64; off <<= 1) v += __shfl_xor(v, off); o[d] = v; }
    if (lane == 0) for (int d = 0; d < HD; ++d) O[rowq * AW + h * HD + d] = (bf16_t)f2bf(o[d] / lsum);
}
__global__ void nv_conv(const bf16_t* U, const bf16_t* CB, const float* cw, bf16_t* Y) {
    const long i = (long)blockIdx.x * blockDim.x + threadIdx.x;
    if (i >= (long)M * CW) return;
    const int c = (int)(i % CW); const long row = i / CW; const int t = (int)(row % SEQ);
    const float u2 = bf2f(U[i]), u1 = t >= 1 ? bf2f(U[i - CW]) : 0.f, u0 = t >= 2 ? bf2f(U[i - 2 * CW]) : 0.f;
    Y[i] = (bf16_t)f2bf(bf2f(CB[i]) * (cw[c] * u0 + cw[CW + c] * u1 + cw[2 * CW + c] * u2));
}
__global__ void nv_final(const float* X, const float* SSQ, const float* g, float* out) {
    const int row = blockIdx.x * 4 + (threadIdx.x >> 6), lane = threadIdx.x & 63;
    const float rs = row_rstd(SSQ, row);
    for (int c = lane; c < DM; c += 64) out[(size_t)row * DM + c] = X[(size_t)row * DM + c] * rs * g[c];
}


namespace pg8 {
#define PG8_LAS __attribute__((address_space(3)))
typedef unsigned short bf16_t;
typedef short bf16x8 __attribute__((ext_vector_type(8)));
typedef float f32x4 __attribute__((ext_vector_type(4)));
typedef unsigned u32x4 __attribute__((ext_vector_type(4)));
constexpr int BM = 256, BK = 64, HALF = 128, HTB = HALF * BK * 2  , STAGE_BYTES = 8 * HTB, NXCD = 8, WGM = 8;

__host__ __device__ __forceinline__ int lds_byte(int r, int c) { const int st = (r >> 4) * 2 + (c >> 5), rr = r & 15, cc = c & 31, ob = rr * 64 + cc * 2; return st * 1024 + (ob ^ (((ob >> 9) & 1) << 5)); }
__host__ __device__ __forceinline__ void stage_rc(int b, int& R, int& C) { const int st = b / 1024, sb = b % 1024, swz = sb ^ (((sb >> 9) & 1) << 5); R = (st >> 1) * 16 + swz / 64; C = (st & 1) * 32 + (swz % 64) / 2; }
__host__ __device__ __forceinline__ int perm32(int rho) { const int n = rho >> 4, i = rho & 15; return 8 * (i >> 2) + 4 * n + (i & 3); }

struct Unit { int pm, pn; };
struct Gemm { const bf16_t* A; const bf16_t* Bt; int M, N, K; };

struct StaticOrder {
    int nM, nN, nwg, G, c;
    __host__ __device__ void init(int M, int N, int G_, int c_) { nM = M / BM; nN = N / BM; nwg = nM * nN; G = G_; c = c_; }
    __host__ __device__ bool next(int i, Unit& u) const {
        const long L = (long)i * G + c; if (L >= nwg) return false;
        int wgid = (int)L; { const int q = nwg / NXCD, r = nwg % NXCD, xcd = wgid % NXCD, off = wgid / NXCD; wgid = (xcd < r ? xcd * (q + 1) : r * (q + 1) + (xcd - r) * q) + off; }
        const int nig = WGM * nN, gid = wgid / nig, fm = gid * WGM, gsz = (nM - fm) < WGM ? (nM - fm) : WGM;
        u.pm = fm + ((wgid % nig) % gsz); u.pn = (wgid % nig) / gsz; return true;
    }
    __device__ __forceinline__ void a_ready(const Unit&) const {}
    __device__ __forceinline__ void done(const Unit&) const {}
};


__device__ __forceinline__ unsigned cvt_pk_bf16(float lo, float hi) { unsigned r; asm volatile("v_cvt_pk_bf16_f32 %0, %1, %2" : "=v"(r) : "v"(lo), "v"(hi)); return r; }

typedef unsigned u32x2 __attribute__((ext_vector_type(2)));
__device__ __forceinline__ float rstd_of(const float* SSQ, int row) {
    const f32x4* p = (const f32x4*)(SSQ + (size_t)row * 16);
    const f32x4 a = p[0], b = p[1], c = p[2], d = p[3];
    const float s = (((a[0] + a[1]) + (a[2] + a[3])) + ((b[0] + b[1]) + (b[2] + b[3]))) + (((c[0] + c[1]) + (c[2] + c[3])) + ((d[0] + d[1]) + (d[2] + d[3])));
    return 1.0f / sqrtf(s * (1.0f / 1024.0f) + 1e-6f);
}
__device__ __forceinline__ float sigmoid_f(float v) { return __builtin_amdgcn_rcpf(1.0f + __builtin_amdgcn_exp2f(v * -1.4426950408889634f)); }
__device__ __forceinline__ u32x4 pack8(const f32x4 a, const f32x4 b) { u32x4 w; w.x = cvt_pk_bf16(a[0], a[1]); w.y = cvt_pk_bf16(a[2], a[3]); w.z = cvt_pk_bf16(b[0], b[1]); w.w = cvt_pk_bf16(b[2], b[3]); return w; }
__device__ __forceinline__ void unpack8(const u32x4 w, f32x4& a, f32x4& b) {
    a[0] = __builtin_bit_cast(float, w.x << 16); a[1] = __builtin_bit_cast(float, w.x & 0xffff0000u); a[2] = __builtin_bit_cast(float, w.y << 16); a[3] = __builtin_bit_cast(float, w.y & 0xffff0000u);
    b[0] = __builtin_bit_cast(float, w.z << 16); b[1] = __builtin_bit_cast(float, w.z & 0xffff0000u); b[2] = __builtin_bit_cast(float, w.w << 16); b[3] = __builtin_bit_cast(float, w.w & 0xffff0000u);
}
struct EpiSwiglu {
    static constexpr bool PERM = true, AFTER_DRAIN = false;
    bf16_t* H; const float* SSQ;
    __device__ __forceinline__ void operator()(const f32x4 (&acc)[2][2][4][2], const Unit& u, int wr, int wc, int fr, int fq) const {
        const int row0 = u.pm * BM + wr * 64 + fr, col0 = u.pn * 128 + wc * 32 + 8 * fq;
#pragma unroll
        for (int ai = 0; ai < 2; ++ai)
#pragma unroll
            for (int m = 0; m < 4; ++m) { const int r = row0 + ai * HALF + m * 16; const float rs = rstd_of(SSQ, r);
                f32x4 h[2];
#pragma unroll
                for (int n = 0; n < 2; ++n) { const f32x4 g = acc[ai][0][m][n] * rs, up = acc[ai][1][m][n] * rs;
#pragma unroll
                    for (int e = 0; e < 4; ++e) h[n][e] = g[e] * sigmoid_f(g[e]) * up[e]; }
                *(u32x4*)(H + (size_t)r * 2816 + col0) = pack8(h[0], h[1]); }
    }
};
struct EpiResid {
    static constexpr bool PERM = true, AFTER_DRAIN = false;
    const float* xin; float* xout; bf16_t* XN; float* SSQ; float alpha; int pad;
    __device__ __forceinline__ void operator()(const f32x4 (&acc)[2][2][4][2], const Unit& u, int wr, int wc, int fr, int fq) const {
        const int row0 = u.pm * BM + wr * 64 + fr, col0 = u.pn * BM + wc * 32 + 8 * fq;
#pragma unroll
        for (int ai = 0; ai < 2; ++ai)
#pragma unroll
            for (int m = 0; m < 4; ++m) { const int r = row0 + ai * HALF + m * 16; const size_t off = (size_t)r * 1024 + col0; float s = 0.f;
#pragma unroll
                for (int bj = 0; bj < 2; ++bj) { const f32x4 x0 = *(const f32x4*)(xin + off + bj * HALF), x1 = *(const f32x4*)(xin + off + bj * HALF + 4);
                    const f32x4 o0 = x0 + acc[ai][bj][m][0] * alpha, o1 = x1 + acc[ai][bj][m][1] * alpha;
                    *(f32x4*)(xout + off + bj * HALF) = o0; *(f32x4*)(xout + off + bj * HALF + 4) = o1;
                    *(u32x4*)(XN + off + bj * HALF) = pack8(o0, o1);
                    s += ((o0[0] * o0[0] + o0[1] * o0[1]) + (o0[2] * o0[2] + o0[3] * o0[3])) + ((o1[0] * o1[0] + o1[1] * o1[1]) + (o1[2] * o1[2] + o1[3] * o1[3])); }
                s += __shfl_xor(s, 16); s += __shfl_xor(s, 32);
                if (fq == 0) SSQ[(size_t)r * 16 + u.pn * 4 + wc] = s;
                if (m & 1) asm volatile("" ::: "memory"); }
    }
};
struct EpiWin {
    static constexpr bool PERM = true, AFTER_DRAIN = false;
    bf16_t *Q, *K, *V, *U, *CB, *GA, *GC; const float* SSQ;
    __device__ __forceinline__ void operator()(const f32x4 (&acc)[2][2][4][2], const Unit& u, int wr, int wc, int fr, int fq) const {
        const int row0 = u.pm * BM + wr * 64 + fr, cw = wc * 32 + 8 * fq, t = u.pn;
        if (t >= 6 && t < 10) {
#pragma unroll
            for (int ai = 0; ai < 2; ++ai)
#pragma unroll
                for (int m = 0; m < 4; ++m) { const int r = row0 + ai * HALF + m * 16; const float rs = rstd_of(SSQ, r), rs2 = rs * rs;
                    *(u32x4*)(U + (size_t)r * 512 + (t - 6) * 128 + cw) = pack8(acc[ai][0][m][0] * acc[ai][1][m][0] * rs2, acc[ai][0][m][1] * acc[ai][1][m][1] * rs2); }
            return;
        }
        bf16_t* dst; int ld, cb; float sc = 1.0f; bool sig = false;
        if (t < 2) { dst = Q; ld = 512; cb = t * 256; sc = 0.125f * 1.4426950408889634f; }
        else if (t < 4) { dst = K; ld = 512; cb = (t - 2) * 256; }
        else if (t < 6) { dst = V; ld = 512; cb = (t - 4) * 256; }
        else if (t < 12) { dst = CB; ld = 512; cb = (t - 10) * 256; }
        else if (t < 16) { dst = GA; ld = 1024; cb = (t - 12) * 256; sig = true; }
        else { dst = GC; ld = 1024; cb = (t - 16) * 256; sig = true; }
#pragma unroll
        for (int ai = 0; ai < 2; ++ai)
#pragma unroll
            for (int m = 0; m < 4; ++m) { const int r = row0 + ai * HALF + m * 16; const float rs = rstd_of(SSQ, r) * sc;
#pragma unroll
                for (int bj = 0; bj < 2; ++bj) { f32x4 v0 = acc[ai][bj][m][0] * rs, v1 = acc[ai][bj][m][1] * rs;
                    if (sig) {
#pragma unroll
                        for (int e = 0; e < 4; ++e) { v0[e] = sigmoid_f(v0[e]); v1[e] = sigmoid_f(v1[e]); } }
                    *(u32x4*)(dst + (size_t)r * ld + cb + bj * HALF + cw) = pack8(v0, v1); } }
    }
};
template <int MODE> struct EpiGate {
    static constexpr bool PERM = true, AFTER_DRAIN = false;
    const bf16_t* G; bf16_t* T;
    __device__ __forceinline__ void operator()(const f32x4 (&acc)[2][2][4][2], const Unit& u, int wr, int wc, int fr, int fq) const {
        const int row0 = u.pm * BM + wr * 64 + fr, col0 = u.pn * BM + wc * 32 + 8 * fq;
#pragma unroll
        for (int ai = 0; ai < 2; ++ai)
#pragma unroll
            for (int m = 0; m < 4; ++m) { const size_t off = (size_t)(row0 + ai * HALF + m * 16) * 1024 + col0;
#pragma unroll
                for (int bj = 0; bj < 2; ++bj) { f32x4 g0, g1; unpack8(*(const u32x4*)(G + off + bj * HALF), g0, g1);
                    f32x4 o0 = g0 * acc[ai][bj][m][0], o1 = g1 * acc[ai][bj][m][1];
                    if (MODE == 1) { f32x4 t0, t1; unpack8(*(const u32x4*)(T + off + bj * HALF), t0, t1); o0 += t0; o1 += t1; }
                    *(u32x4*)(T + off + bj * HALF) = pack8(o0, o1); }
                if (m & 1) asm volatile("" ::: "memory"); }
    }
};
template <class Epi, class Sched, bool ALIGN_EPI = false, bool SP2 = false>
__device__ __forceinline__ void gemm_phase(PG8_LAS unsigned char* lds, const Gemm g, const Sched& S, const Epi& E) {
    const int tid = threadIdx.x, wid = __builtin_amdgcn_readfirstlane(tid >> 6), lane = tid & 63, wr = wid >> 2, wc = wid & 3, fr = lane & 15, fq = lane >> 4;
    const int K = g.K, nt = K / BK;
    unsigned voffA[2], voffB[2];
#pragma unroll
    for (int i = 0; i < 2; ++i) { int R, C; stage_rc(tid * 16 + i * 8192, R, C); const int Rb = Epi::PERM ? ((R & ~31) + perm32(R & 31)) : R;
        voffA[i] = (unsigned)(R * K + C) * 2u; voffB[i] = (unsigned)(Rb * K + C) * 2u; }
    const size_t kstep = (size_t)(BK * 2);
    const size_t hstep = (size_t)HALF * K * 2;
    const size_t tstep = 2 * hstep;
    const unsigned ldsw = (unsigned)wid * 1024u;
    const int aoff = lds_byte(wr * 64 + fr, fq * 8), boff = lds_byte(wc * 32 + fr, fq * 8);
#define PG8_SA(b, h) (((b) * 2 + (h)) * HTB)
#define PG8_SB(b, h) ((4 + (b) * 2 + (h)) * HTB)
#define PG8_STAGE(bufoff, gbase, voff) do { _Pragma("unroll") for (int _i = 0; _i < 2; ++_i) \
        __builtin_amdgcn_global_load_lds((const unsigned*)((const char*)(gbase) + (voff)[_i]), (PG8_LAS unsigned*)(lds + (bufoff) + ldsw + _i * 8192), 16, 0, 0); } while (0)
#define PG8_LDA(dst, b, h) do { _Pragma("unroll") for (int m = 0; m < 4; ++m) _Pragma("unroll") for (int k = 0; k < 2; ++k) dst[m][k] = *(const PG8_LAS bf16x8*)(lds + PG8_SA(b, h) + aoff + m * 2048 + k * 1024); } while (0)
#define PG8_LDB(dst, b, h) do { _Pragma("unroll") for (int n = 0; n < 2; ++n) _Pragma("unroll") for (int k = 0; k < 2; ++k) dst[n][k] = *(const PG8_LAS bf16x8*)(lds + PG8_SB(b, h) + boff + n * 2048 + k * 1024); } while (0)
#define PG8_MMA(ai, bj, At, Bt) do { __builtin_amdgcn_s_setprio(1); _Pragma("unroll") for (int m = 0; m < 4; ++m) _Pragma("unroll") for (int n = 0; n < 2; ++n) _Pragma("unroll") for (int k = 0; k < 2; ++k) \
        acc[ai][bj][m][n] = __builtin_amdgcn_mfma_f32_16x16x32_bf16(Bt[n][k], At[m][k], acc[ai][bj][m][n], 0, 0, 0); __builtin_amdgcn_s_setprio(0); } while (0)
#define PG8_WAIT_V(n) asm volatile("s_waitcnt vmcnt(" #n ")" ::: "memory")
#define PG8_WAIT_L(n) asm volatile("s_waitcnt lgkmcnt(" #n ")" ::: "memory")
#define PG8_BAR __builtin_amdgcn_s_barrier()
#define PG8_SCHED __builtin_amdgcn_sched_barrier(0)
    Unit cur, nxt; int ui = 0;
    if (!S.next(0, cur)) return;
    f32x4 acc[2][2][4][2];
#pragma unroll
    for (int a = 0; a < 2; ++a)
#pragma unroll
        for (int b = 0; b < 2; ++b)
#pragma unroll
            for (int m = 0; m < 4; ++m)
#pragma unroll
                for (int n = 0; n < 2; ++n) acc[a][b][m][n] = (f32x4){0.f, 0.f, 0.f, 0.f};
    bf16x8 At[4][2], B0[2][2], B1[2][2];
    const char* cA = (const char*)g.A + (size_t)cur.pm * tstep; const char* cB = (const char*)g.Bt + (size_t)cur.pn * tstep;
    S.a_ready(cur);
    if constexpr (SP2) {
        PG8_STAGE(PG8_SB(0, 0), cB, voffB); PG8_STAGE(PG8_SB(0, 1), cB + hstep, voffB); PG8_STAGE(PG8_SA(0, 0), cA, voffA); PG8_STAGE(PG8_SA(0, 1), cA + hstep, voffA);
        if (wr == 1) PG8_BAR;
        PG8_WAIT_V(2); PG8_BAR;
        PG8_STAGE(PG8_SB(1, 0), cB + kstep, voffB); PG8_STAGE(PG8_SA(1, 0), cA + kstep, voffA); PG8_STAGE(PG8_SB(1, 1), cB + hstep + kstep, voffB);
        PG8_WAIT_V(6); PG8_BAR;
    } else {
        PG8_STAGE(PG8_SB(0, 0), cB, voffB); PG8_STAGE(PG8_SA(0, 0), cA, voffA); PG8_STAGE(PG8_SB(0, 1), cB + hstep, voffB); PG8_STAGE(PG8_SA(0, 1), cA + hstep, voffA);
        if (wr == 1) PG8_BAR;
        PG8_WAIT_V(4); PG8_BAR;
        PG8_STAGE(PG8_SB(1, 0), cB + kstep, voffB); PG8_STAGE(PG8_SA(1, 0), cA + kstep, voffA); PG8_STAGE(PG8_SB(1, 1), cB + hstep + kstep, voffB);
        PG8_WAIT_V(6); PG8_BAR;
    }
    for (;;) {
        const bool has_next = S.next(ui + 1, nxt);
        const char* nA = has_next ? (const char*)g.A + (size_t)nxt.pm * tstep : cA; const char* nB = has_next ? (const char*)g.Bt + (size_t)nxt.pn * tstep : cB;
        for (int t = 0; t < nt; t += 2) {
            const bool last = (t == nt - 2);
            const char* a1 = cA + (size_t)(t + 1) * kstep;
            const char* a2 = last ? nA : cA + (size_t)(t + 2) * kstep; const char* b2 = last ? nB : cB + (size_t)(t + 2) * kstep;
            const char* a3 = a2 + kstep; const char* b3 = b2 + kstep;
            if (last && has_next) S.a_ready(nxt);
            if constexpr (SP2) {
            PG8_LDB(B0, 0, 0); PG8_LDB(B1, 0, 1); PG8_SCHED; PG8_LDA(At, 0, 0); PG8_STAGE(PG8_SA(1, 1), a1 + hstep, voffA);
            PG8_WAIT_V(8); PG8_WAIT_L(0); PG8_BAR; PG8_MMA(0, 0, At, B0); PG8_MMA(0, 1, At, B1); PG8_BAR; PG8_SCHED;
            PG8_LDA(At, 0, 1); PG8_STAGE(PG8_SB(0, 0), b2, voffB); PG8_STAGE(PG8_SB(0, 1), b2 + hstep, voffB); PG8_STAGE(PG8_SA(0, 0), a2, voffA);
            PG8_WAIT_V(8); PG8_WAIT_L(0); PG8_BAR; PG8_MMA(1, 0, At, B0); PG8_MMA(1, 1, At, B1); PG8_BAR; PG8_SCHED;
            PG8_LDB(B0, 1, 0); PG8_LDB(B1, 1, 1); PG8_SCHED; PG8_LDA(At, 1, 0); PG8_STAGE(PG8_SA(0, 1), a2 + hstep, voffA);
            PG8_WAIT_V(8); PG8_WAIT_L(0); PG8_BAR; PG8_MMA(0, 0, At, B0); PG8_MMA(0, 1, At, B1); PG8_BAR; PG8_SCHED;
            PG8_LDA(At, 1, 1); PG8_STAGE(PG8_SB(1, 0), b3, voffB); PG8_STAGE(PG8_SB(1, 1), b3 + hstep, voffB); PG8_STAGE(PG8_SA(1, 0), a3, voffA);
            PG8_WAIT_V(8); PG8_WAIT_L(0); PG8_BAR; PG8_MMA(1, 0, At, B0); PG8_MMA(1, 1, At, B1); PG8_BAR; PG8_SCHED;
            } else {
            PG8_LDB(B0, 0, 0); PG8_SCHED; PG8_LDA(At, 0, 0); PG8_STAGE(PG8_SA(1, 1), a1 + hstep, voffA);
            PG8_WAIT_L(8); PG8_BAR; PG8_WAIT_L(0); PG8_MMA(0, 0, At, B0); PG8_BAR; PG8_SCHED;
            PG8_LDB(B1, 0, 1); PG8_STAGE(PG8_SB(0, 0), b2, voffB);
            PG8_BAR; PG8_WAIT_L(0); PG8_MMA(0, 1, At, B1); PG8_BAR;
            PG8_LDA(At, 0, 1); PG8_STAGE(PG8_SA(0, 0), a2, voffA);
            PG8_BAR; PG8_WAIT_L(0); PG8_MMA(1, 0, At, B0); PG8_BAR; PG8_SCHED;
            PG8_STAGE(PG8_SB(0, 1), b2 + hstep, voffB);
            PG8_WAIT_V(6); PG8_BAR; PG8_MMA(1, 1, At, B1); PG8_BAR;
            PG8_LDB(B0, 1, 0); PG8_SCHED; PG8_LDA(At, 1, 0); PG8_STAGE(PG8_SA(0, 1), a2 + hstep, voffA);
            PG8_WAIT_L(8); PG8_BAR; PG8_WAIT_L(0); PG8_MMA(0, 0, At, B0); PG8_BAR; PG8_SCHED;
            PG8_LDB(B1, 1, 1); PG8_STAGE(PG8_SB(1, 0), b3, voffB);
            PG8_BAR; PG8_WAIT_L(0); PG8_MMA(0, 1, At, B1); PG8_BAR;
            PG8_LDA(At, 1, 1); PG8_STAGE(PG8_SA(1, 0), a3, voffA);
            PG8_BAR; PG8_WAIT_L(0); PG8_MMA(1, 0, At, B0); PG8_BAR; PG8_SCHED;
            PG8_STAGE(PG8_SB(1, 1), b3 + hstep, voffB);
            PG8_WAIT_V(6); PG8_BAR; PG8_MMA(1, 1, At, B1); PG8_BAR;
            }
        }
        if constexpr (ALIGN_EPI) { if (wr == 0) PG8_BAR; }
        if constexpr (!Epi::AFTER_DRAIN) { E(acc, cur, wr, wc, fr, fq); S.done(cur); }
        if (!has_next) break;
#pragma unroll
        for (int a = 0; a < 2; ++a)
#pragma unroll
            for (int b = 0; b < 2; ++b)
#pragma unroll
                for (int m = 0; m < 4; ++m)
#pragma unroll
                    for (int n = 0; n < 2; ++n) acc[a][b][m][n] = (f32x4){0.f, 0.f, 0.f, 0.f};
        cur = nxt; cA = nA; cB = nB; ++ui;
        if constexpr (ALIGN_EPI) { if (wr == 1) PG8_BAR; }
    }
    PG8_WAIT_V(0);
    if constexpr (!ALIGN_EPI) { if (wr == 0) PG8_BAR; }
    PG8_BAR;
    if constexpr (Epi::AFTER_DRAIN) { E.fused(acc, cur, wr, wc, fr, fq, lds, wid, lane); S.done(cur); }
#undef PG8_SA
#undef PG8_SB
#undef PG8_STAGE
#undef PG8_LDA
#undef PG8_LDB
#undef PG8_MMA
#undef PG8_WAIT_V
#undef PG8_WAIT_L
#undef PG8_BAR
#undef PG8_SCHED
}
}

#ifndef PG8_SP2
#define PG8_SP2 true
#endif
#ifndef PG8_ALIGN
#define PG8_ALIGN true
#endif
#include <hip/hip_bf16.h>
#include <cmath>
namespace attn_body {
using bf16=__hip_bfloat16;
using bf16x8=__attribute__((ext_vector_type(8)))short;
using s16x4=__attribute__((ext_vector_type(4)))short;
using f32x16=__attribute__((ext_vector_type(16)))float;
using u32x4=__attribute__((ext_vector_type(4)))unsigned;
constexpr int BATCH=16,NHEAD=8,SEQ=2048,D=64,DM=NHEAD*D;
constexpr int NW=8,QBLK=32,QB=QBLK*NW,KVBLK=64,NQB=SEQ/QB;
constexpr int ATTN_PITCH=DM, ATTN_UNIT_ROWS=QB;
__device__ __forceinline__ int crow(int r,int hi){return (r&3)+8*(r>>2)+4*hi;}
#define SBAR() __builtin_amdgcn_sched_barrier(0)
__device__ __forceinline__ void cmask(f32x16&p0,f32x16&p1,int jb,int qrel,int hi){
  const float NEG=-INFINITY; int kb=64*jb+4*hi;
  #pragma unroll
  for(int r=0;r<16;++r){int kv=kb+(r&3)+8*(r>>2); if(kv>qrel)p0[r]=NEG; if(kv+32>qrel)p1[r]=NEG;}
}

constexpr int NSLOT=3, SLOTB=8192;
constexpr int LDS_K=0, LDS_V=NSLOT*SLOTB, LDS_WS=2*NSLOT*SLOTB, LDS_OST=LDS_WS+NW*64*4, LDS_CK=LDS_OST+NW*4096, LDS_BYTES=LDS_CK+SEQ*16;
constexpr float C2=0.125f*1.4426950408889634f;
__device__ __forceinline__ void glds16(const void*gsrc,unsigned lds_dst){unsigned keep;
  asm volatile("s_mov_b32 %0, m0\n\ts_mov_b32 m0, %2\n\ts_nop 0\n\tglobal_load_lds_dwordx4 %1, off\n\ts_mov_b32 m0, %0":"=&s"(keep):"v"(gsrc),"s"(lds_dst):"memory");}
__device__ __forceinline__ float max3f(float a,float b,float c){float r;asm("v_max3_f32 %0, %1, %2, %3":"=v"(r):"v"(a),"v"(b),"v"(c));return r;}
__device__ __forceinline__ float max2f(float a,float b){float r;asm("v_max_f32_e32 %0, %1, %2":"=v"(r):"v"(a),"v"(b));return r;}
__device__ __forceinline__ float fadd_s(float a,float b){float r;asm("v_add_f32_e32 %0, %1, %2":"=v"(r):"v"(a),"v"(b));return r;}
__device__ __forceinline__ float fsub_s(float a,float b){float r;asm("v_sub_f32_e32 %0, %1, %2":"=v"(r):"v"(a),"v"(b));return r;}
typedef float f32x2_t __attribute__((ext_vector_type(2))); typedef __bf16 bf16x2_t __attribute__((ext_vector_type(2)));
__device__ __forceinline__ unsigned cvtpk_s(float lo,float hi){f32x2_t v={lo,hi};bf16x2_t b=__builtin_convertvector(v,bf16x2_t);return __builtin_bit_cast(unsigned,b);}
#define WAIT_BAR(N) asm volatile("s_waitcnt vmcnt(" #N ") lgkmcnt(0)\n\ts_barrier":::"memory")

__device__ __forceinline__ void qkt(f32x16&p0,f32x16&p1,const char*Kslot,const bf16x8*qr,const f32x16&negm,int r32,int hi){
  const char*kb=Kslot+hi*1024+r32*16;
  #pragma unroll
  for(int d0=0;d0<4;++d0){
    const bf16x8 b0=*reinterpret_cast<const bf16x8*>(kb+d0*2048);
    const bf16x8 b1=*reinterpret_cast<const bf16x8*>(kb+d0*2048+512);
    if(d0==0){p0=__builtin_amdgcn_mfma_f32_32x32x16_bf16(b0,qr[0],negm,0,0,0);p1=__builtin_amdgcn_mfma_f32_32x32x16_bf16(b1,qr[0],negm,0,0,0);}
    else{p0=__builtin_amdgcn_mfma_f32_32x32x16_bf16(b0,qr[d0],p0,0,0,0);p1=__builtin_amdgcn_mfma_f32_32x32x16_bf16(b1,qr[d0],p1,0,0,0);}}
}
typedef __attribute__((address_space(3))) const char* lds_cptr;
typedef short v4i16_t __attribute__((ext_vector_type(4)));
__device__ __forceinline__ void kload8(bf16x8*kf,lds_cptr kp){
  kf[0]=*(const __attribute__((address_space(3))) bf16x8*)(kp);      kf[1]=*(const __attribute__((address_space(3))) bf16x8*)(kp+512);
  kf[2]=*(const __attribute__((address_space(3))) bf16x8*)(kp+2048); kf[3]=*(const __attribute__((address_space(3))) bf16x8*)(kp+2560);
  kf[4]=*(const __attribute__((address_space(3))) bf16x8*)(kp+4096); kf[5]=*(const __attribute__((address_space(3))) bf16x8*)(kp+4608);
  kf[6]=*(const __attribute__((address_space(3))) bf16x8*)(kp+6144); kf[7]=*(const __attribute__((address_space(3))) bf16x8*)(kp+6656);
}
__device__ __forceinline__ void kload2(bf16x8*kf,lds_cptr kp,int j){ kf[2*j]=*(const __attribute__((address_space(3))) bf16x8*)(kp+j*2048); kf[2*j+1]=*(const __attribute__((address_space(3))) bf16x8*)(kp+j*2048+512); }
__device__ __forceinline__ s16x4 vtr(lds_cptr p){ return __builtin_bit_cast(s16x4,__builtin_amdgcn_ds_read_tr16_b64_v4i16((__attribute__((address_space(3))) v4i16_t*)p)); }
__device__ __forceinline__ float rowmax(const f32x16&p0,const f32x16&p1){
  float a=max3f(p0[0],p0[1],p1[0]),b=max3f(p0[2],p0[3],p1[1]);a=max3f(a,p1[2],p1[3]);
  #pragma unroll
  for(int r=4;r<16;r+=4){a=max3f(a,p0[r],p0[r+1]);b=max3f(b,p0[r+2],p0[r+3]);a=max3f(a,p1[r],p1[r+1]);b=max3f(b,p1[r+2],p1[r+3]);}
  const float m=max2f(a,b);
  auto rr=__builtin_amdgcn_permlane32_swap(__float_as_uint(m),__float_as_uint(m),false,false);
  return max2f(__uint_as_float(rr[0]),__uint_as_float(rr[1]));
}
__device__ __forceinline__ void pv(f32x16*o,int vb,bf16x8 pa0,bf16x8 pa1,bf16x8 pa2,bf16x8 pa3){
  #pragma unroll
  for(int d0=0;d0<2;++d0){s16x4 lo[4],hi[4];
    #pragma unroll
    for(int ks=0;ks<4;++ks){
      asm volatile("ds_read_b64_tr_b16 %0,%1 offset:%c2":"=&v"(lo[ks]):"v"(vb),"i"(d0*4096+ks*1024):"memory");
      asm volatile("ds_read_b64_tr_b16 %0,%1 offset:%c2":"=&v"(hi[ks]):"v"(vb),"i"(d0*4096+ks*1024+512):"memory");}
    asm volatile("s_waitcnt lgkmcnt(0)":::"memory");SBAR();
    #define PK(k) (bf16x8){lo[k][0],lo[k][1],lo[k][2],lo[k][3],hi[k][0],hi[k][1],hi[k][2],hi[k][3]}
    o[d0]=__builtin_amdgcn_mfma_f32_32x32x16_bf16(pa0,PK(0),o[d0],0,0,0);
    o[d0]=__builtin_amdgcn_mfma_f32_32x32x16_bf16(pa1,PK(1),o[d0],0,0,0);
    o[d0]=__builtin_amdgcn_mfma_f32_32x32x16_bf16(pa2,PK(2),o[d0],0,0,0);
    o[d0]=__builtin_amdgcn_mfma_f32_32x32x16_bf16(pa3,PK(3),o[d0],0,0,0);
    #undef PK
  }
}

#ifndef ATTN_STORE16
#define ATTN_STORE16(p,v) (*(u32x4*)(p)=(v))
#endif
__device__ __forceinline__ unsigned f2bf_(float f){unsigned u=__builtin_bit_cast(unsigned,f);return (u+0x7fffu+((u>>16)&1u))>>16;}
__device__ __forceinline__ float bf2f_(unsigned h){return __builtin_bit_cast(float,h<<16);}
__device__ __forceinline__ bf16x8 make_qx(float base,int hi){
  const unsigned u1=f2bf_(base); const float r1=base-bf2f_(u1); const unsigned u2=f2bf_(r1); const float r2=r1-bf2f_(u2); const unsigned u3=f2bf_(r2);
  u32x4 w; w.x=hi?0u:(u1|(u2<<16)); w.y=hi?0u:(u3|0xBF800000u); w.z=hi?0u:0xBF80BF80u; w.w=0u; return __builtin_bit_cast(bf16x8,w); }
template<int THRL> __device__ __forceinline__ void attn_unit(int b,int h,int qb,const bf16*Q,const bf16*__restrict__ K,const bf16*__restrict__ V,bf16*O,const float*LC,const float*TOT,char*shm){
  const int tid=threadIdx.x,lane=tid&63,r32=lane&31,hi=lane>>5; const int wid=__builtin_amdgcn_readfirstlane(tid>>6);
  const long rowbase=(long)b*SEQ; const int q0=qb*QB;
  const bf16*Qw=Q+(rowbase+q0+wid*QBLK)*DM+h*D;
  const bf16*Kh=K+rowbase*DM+h*D,*Vh=V+rowbase*DM+h*D;
  const unsigned lds0=(unsigned)(uintptr_t)shm;
  float*wsf=(float*)(shm+LDS_WS)+wid*64;
  const bf16*ksrc=Kh+(long)lane*DM+wid*8;
  const bf16*vsrc=Vh+(long)(16*(wid&3)+(lane>>2))*DM+(wid>>2)*32+(lane&3)*8;
  const unsigned kdst=lds0+LDS_K+wid*1024, vdst=lds0+LDS_V+wid*1024;
  #define DMA_K(t,slot) glds16(ksrc+(long)(t)*KVBLK*DM,(unsigned)__builtin_amdgcn_readfirstlane(kdst+(slot)))
  #define DMA_V(t,slot) glds16(vsrc+(long)(t)*KVBLK*DM,(unsigned)__builtin_amdgcn_readfirstlane(vdst+(slot)))
  const int vb0=(int)(lds0+LDS_V)+((lane>>4)&1)*32+(lane&3)*8+(4*hi+((lane&15)>>2))*64;
  const char*Kbase=shm+LDS_K; bf16x8 kf[8];
  const lds_cptr shm3=(lds_cptr)shm; const lds_cptr kp0=shm3+LDS_K+hi*1024+r32*16; const lds_cptr vp0=shm3+LDS_V+((lane>>4)&1)*32+(lane&3)*8+(4*hi+((lane&15)>>2))*64;
  const int NT=(q0+QB)/KVBLK;
  DMA_K(0,0);DMA_V(0,0);DMA_K(1,SLOTB);
  float cq;
  { const float*LCbh=LC+((long)b*NHEAD+h)*SEQ;
    __attribute__((address_space(3))) u32x4*ckx=(__attribute__((address_space(3))) u32x4*)((__attribute__((address_space(3))) char*)shm+LDS_CK);
    const float tv=(lane<16)?TOT[((long)b*16+lane)*NHEAD+h]:0.f; float inc=tv;
    #pragma unroll
    for(int o_=1;o_<16;o_<<=1){const float u_=__shfl_up(inc,o_); if(lane>=o_)inc+=u_;}
    const float exc=inc-tv;
    for(int i=tid;i<q0+QB;i+=NW*64){ const float v=LCbh[i]+__shfl(exc,i>>7);
      const unsigned u1=f2bf_(v); const float r1=v-bf2f_(u1); const unsigned u2=f2bf_(r1); const float r2=r1-bf2f_(u2); const unsigned u3=f2bf_(r2);
      u32x4 w; w.x=0x3F803F80u; w.y=0x3F80u|(u1<<16); w.z=u2|(u3<<16); w.w=0u; ckx[i]=w; }
    const int qrow=q0+wid*QBLK+r32; cq=LCbh[qrow]+__shfl(exc,qrow>>7); }
  const lds_cptr ckxp=(lds_cptr)shm+LDS_CK+r32*16;
  #define KXMMA(C0,C1,t) do{ const bf16x8 kx0_=*(const __attribute__((address_space(3))) bf16x8*)(ckxp+(t)*1024), kx1_=*(const __attribute__((address_space(3))) bf16x8*)(ckxp+(t)*1024+512); \
    C0=__builtin_amdgcn_mfma_f32_32x32x16_bf16(kx0_,qx,C0,0,0,0); C1=__builtin_amdgcn_mfma_f32_32x32x16_bf16(kx1_,qx,C1,0,0,0); SBAR(); }while(0)
  bf16x8 qr[4];
  #pragma unroll
  for(int d0=0;d0<4;++d0)qr[d0]=*reinterpret_cast<const bf16x8*>(&Qw[(long)r32*DM+d0*16+hi*8]);
  float mhat=0.f,l_reg=0.f;f32x16 o[2];o[0]=f32x16{};o[1]=f32x16{};bf16x8 qx=make_qx(cq,hi);
  const int qrel=wid*QBLK+r32;
  #define CMASK(P0,P1,t) do{int jb_=(t)-(NT-4); if(jb_>=0)cmask(P0,P1,jb_,qrel,hi);}while(0)
  bool resc=false;
  #define START(P0,P1) do{ const float rm=rowmax(P0,P1); resc=false; \
    { const float dl=rm; mhat=fadd_s(mhat,dl); \
      _Pragma("unroll") for(int r=0;r<16;++r){P0[r]=fsub_s(P0[r],dl);P1[r]=fsub_s(P1[r],dl);} \
      qx=make_qx(cq-mhat,hi); } \
    _Pragma("unroll") for(int r=0;r<16;++r)P0[r]=__builtin_amdgcn_exp2f(P0[r]); }while(0)
  #define RESC() do{ if(resc){ asm volatile("s_waitcnt lgkmcnt(0)":::"memory"); \
      _Pragma("unroll") for(int d_=0;d_<2;++d_) _Pragma("unroll") for(int r=0;r<16;++r)o[d_][r]*=wsf[crow(r,hi)]; } }while(0)
  f32x16 pA0,pA1,pB0,pB1;
  int sl_prev=0,sl_cur=0,sl_next=SLOTB;
  #define ROT() do{sl_prev=sl_cur;sl_cur=sl_next;sl_next=(sl_next==(NSLOT-1)*SLOTB)?0:sl_next+SLOTB;}while(0)
  DMA_K(2,2*SLOTB);
  WAIT_BAR(3);
  qkt(pA0,pA1,Kbase,qr,f32x16{},r32,hi);KXMMA(pA0,pA1,0);asm volatile("s_nop 15\n\ts_nop 7":"+v"(pA0),"+v"(pA1));CMASK(pA0,pA1,0);
  START(pA0,pA1);
  _Pragma("unroll") for(int r=0;r<16;++r)pA1[r]=__builtin_amdgcn_exp2f(pA1[r]);
  WAIT_BAR(0);
  DMA_K(3,0);DMA_V(1,SLOTB);
  ROT();
  kload8(kf,kp0+sl_cur);
  WAIT_BAR(2);
  s16x4 vlo[8],vhi[8]; u32x4 pw0,pw1,pw2,pw3;
  #define PKW(P,B) cvtpk_s(P[B],P[B+1])
  #define PAF(k) __builtin_bit_cast(bf16x8,pw##k)
  #define VFR(i) (bf16x8){vlo[i][0],vlo[i][1],vlo[i][2],vlo[i][3],vhi[i][0],vhi[i][1],vhi[i][2],vhi[i][3]}
  #define PIN(x) asm volatile("":"+v"(x))
  #define MX3(a,b,c) __builtin_fmaxf(__builtin_fmaxf((a),(b)),(c))
  #define GAPA(MF,A0,A1,A2,A3,W0,W1,PW) do{ MF; sacc+=A0; sacc+=A1; sacc+=A2; sacc+=A3; PIN(sacc); W0; W1; PIN(PW); SBAR(); }while(0)
  #define EX(v) __builtin_amdgcn_exp2f(v)
  #define GAPB(MF,X,B) do{ MF; X[B]=EX(X[B]); X[B+1]=EX(X[B+1]); X[B+2]=EX(X[B+2]); X[B+3]=EX(X[B+3]); PIN(X); SBAR(); }while(0)
  #define VRD(i) do{ vlo[i]=vtr(vp_+(((i)>>2)*4096+((i)&3)*1024)); vhi[i]=vtr(vp_+(((i)>>2)*4096+((i)&3)*1024+512)); }while(0)
  #define KRD(G,j) do{ if(G){ kload2(kf,kp0+sl_next,j); SBAR(); } }while(0)
  #define STEP(C0,C1,P0,P1,t,GK,GV,GL) do{ SBAR(); \
    const lds_cptr vp_=vp0+sl_prev; \
    VRD(0); SBAR(); float sacc=(P0[0]+P0[1]); \
    GAPA(C0=__builtin_amdgcn_mfma_f32_32x32x16_bf16(kf[0],qr[0],f32x16{},0,0,0), P0[2],P0[3],P0[4],P0[5],     pw0[0]=PKW(P0,0), pw0[1]=PKW(P0,2), pw0); \
    VRD(4); SBAR(); GAPA(C1=__builtin_amdgcn_mfma_f32_32x32x16_bf16(kf[1],qr[0],f32x16{},0,0,0), P0[6],P0[7],P0[8],P0[9],     pw0[2]=PKW(P0,4), pw0[3]=PKW(P0,6), pw0); \
    VRD(1); SBAR(); GAPA(C0=__builtin_amdgcn_mfma_f32_32x32x16_bf16(kf[2],qr[1],C0,0,0,0),   P0[10],P0[11],P0[12],P0[13], pw1[0]=PKW(P0,8), pw1[1]=PKW(P0,10), pw1); \
    VRD(5); SBAR(); GAPA(C1=__builtin_amdgcn_mfma_f32_32x32x16_bf16(kf[3],qr[1],C1,0,0,0),   P0[14],P0[15],P1[0],P1[1],   pw1[2]=PKW(P0,12),pw1[3]=PKW(P0,14), pw1); \
    VRD(2); SBAR(); GAPA(C0=__builtin_amdgcn_mfma_f32_32x32x16_bf16(kf[4],qr[2],C0,0,0,0),   P1[2],P1[3],P1[4],P1[5],     pw2[0]=PKW(P1,0), pw2[1]=PKW(P1,2), pw2); \
    VRD(6); SBAR(); GAPA(C1=__builtin_amdgcn_mfma_f32_32x32x16_bf16(kf[5],qr[2],C1,0,0,0),   P1[6],P1[7],P1[8],P1[9],     pw2[2]=PKW(P1,4), pw2[3]=PKW(P1,6), pw2); \
    VRD(3); SBAR(); GAPA(C0=__builtin_amdgcn_mfma_f32_32x32x16_bf16(kf[6],qr[3],C0,0,0,0),   P1[10],P1[11],P1[12],P1[13], pw3[0]=PKW(P1,8), pw3[1]=PKW(P1,10), pw3); \
    VRD(7); SBAR(); GAPA(C1=__builtin_amdgcn_mfma_f32_32x32x16_bf16(kf[7],qr[3],C1,0,0,0),   P1[14],P1[15],0.f,0.f,       pw3[2]=PKW(P1,12),pw3[3]=PKW(P1,14), pw3); \
    KXMMA(C0,C1,t); \
    l_reg+=sacc; \
    if(GK){DMA_K((t)+3,sl_cur);} if(GV){DMA_V((t)+1,sl_next);} \
    CMASK(C0,C1,t); \
    { float a=MX3(C0[0],C0[1],C1[0]),b=MX3(C0[2],C0[3],C1[1]); a=MX3(a,C1[2],C1[3]); \
      _Pragma("unroll") for(int r=4;r<16;r+=4){a=MX3(a,C0[r],C0[r+1]);b=MX3(b,C0[r+2],C0[r+3]);a=MX3(a,C1[r],C1[r+1]);b=MX3(b,C1[r+2],C1[r+3]);} \
      float rm=__builtin_fmaxf(a,b); { auto rr=__builtin_amdgcn_permlane32_swap(__float_as_uint(rm),__float_as_uint(rm),false,false); rm=__builtin_fmaxf(__uint_as_float(rr[0]),__uint_as_float(rr[1])); } \
      resc=false; \
      if(__builtin_expect(__any(rm>(float)THRL),0)){ const float dl=__builtin_fmaxf(rm,0.f); mhat+=dl; \
        _Pragma("unroll") for(int r=0;r<16;++r){C0[r]-=dl;C1[r]-=dl;} \
        qx=make_qx(cq-mhat,hi); \
        const float f=__builtin_amdgcn_exp2f(-dl); l_reg*=f; if(hi==0)wsf[r32]=f; resc=true; } } \
    SBAR(); \
    GAPB(o[0]=__builtin_amdgcn_mfma_f32_32x32x16_bf16(PAF(0),VFR(0),o[0],0,0,0), C0,0); \
    GAPB(o[1]=__builtin_amdgcn_mfma_f32_32x32x16_bf16(PAF(0),VFR(4),o[1],0,0,0), C0,4); \
    KRD(GL,0); GAPB(o[0]=__builtin_amdgcn_mfma_f32_32x32x16_bf16(PAF(1),VFR(1),o[0],0,0,0), C0,8); \
    KRD(GL,1); GAPB(o[1]=__builtin_amdgcn_mfma_f32_32x32x16_bf16(PAF(1),VFR(5),o[1],0,0,0), C0,12); \
    KRD(GL,2); GAPB(o[0]=__builtin_amdgcn_mfma_f32_32x32x16_bf16(PAF(2),VFR(2),o[0],0,0,0), C1,0); \
    KRD(GL,3); GAPB(o[1]=__builtin_amdgcn_mfma_f32_32x32x16_bf16(PAF(2),VFR(6),o[1],0,0,0), C1,4); \
    GAPB(o[0]=__builtin_amdgcn_mfma_f32_32x32x16_bf16(PAF(3),VFR(3),o[0],0,0,0), C1,8); \
    GAPB(o[1]=__builtin_amdgcn_mfma_f32_32x32x16_bf16(PAF(3),VFR(7),o[1],0,0,0), C1,12); \
    }while(0)
  int t=1;
  #undef CMASK
  #define CMASK(P0,P1,t) do{}while(0)
  for(;t+5<NT;t+=2){
    STEP(pB0,pB1,pA0,pA1,t,true,true,true);     WAIT_BAR(2); RESC(); ROT();
    STEP(pA0,pA1,pB0,pB1,t+1,true,true,true);   WAIT_BAR(2); RESC(); ROT();
  }
  #undef CMASK
  #define CMASK(P0,P1,t) do{int jb_=(t)-(NT-4); if(jb_>=0)cmask(P0,P1,jb_,qrel,hi);}while(0)
  #define ENDW(tt) do{ if((tt)+3<NT){WAIT_BAR(2);} else if((tt)+2<NT){WAIT_BAR(1);} else {WAIT_BAR(0);} }while(0)
  for(;t+1<NT;t+=2){
    STEP(pB0,pB1,pA0,pA1,t,(t+3<NT),(t+1<NT),(t+1<NT));       ENDW(t);   RESC(); ROT();
    STEP(pA0,pA1,pB0,pB1,t+1,(t+4<NT),(t+2<NT),(t+2<NT));     ENDW(t+1); RESC(); ROT();
  }
  STEP(pB0,pB1,pA0,pA1,NT-1,false,false,false); RESC();
  { float sacc=pB0[0]+pB0[1]; _Pragma("unroll") for(int r=2;r<16;++r)sacc+=pB0[r]; _Pragma("unroll") for(int r=0;r<16;++r)sacc+=pB1[r]; l_reg+=sacc;
    pw0=(u32x4){PKW(pB0,0),PKW(pB0,2),PKW(pB0,4),PKW(pB0,6)};pw1=(u32x4){PKW(pB0,8),PKW(pB0,10),PKW(pB0,12),PKW(pB0,14)};pw2=(u32x4){PKW(pB1,0),PKW(pB1,2),PKW(pB1,4),PKW(pB1,6)};pw3=(u32x4){PKW(pB1,8),PKW(pB1,10),PKW(pB1,12),PKW(pB1,14)};
    SBAR(); pv(o,vb0+sl_cur,PAF(0),PAF(1),PAF(2),PAF(3)); }
  #undef PKW
  #undef PAF
  #undef VFR
  #undef PIN
  #undef MX3
  #undef GAPA
  #undef GAPB
  #undef EX
  #undef VRD
  #undef KRD
  #undef STEP
  #undef ENDW
  {auto rr=__builtin_amdgcn_permlane32_swap(__float_as_uint(l_reg),__float_as_uint(l_reg),false,false);l_reg=__uint_as_float(rr[0])+__uint_as_float(rr[1]);}
  if(hi==0)wsf[32+r32]=l_reg;asm volatile("s_waitcnt lgkmcnt(0)":::"memory");
  float rli[16];
  #pragma unroll
  for(int r=0;r<16;++r)rli[r]=__builtin_amdgcn_rcpf(wsf[32+crow(r,hi)]);
  bf16*Ow=O+(rowbase+q0+wid*QBLK)*DM+h*D;
  { bf16*stg=(bf16*)(shm+LDS_OST)+wid*2048;
    #pragma unroll
    for(int r=0;r<16;++r){const int orow=crow(r,hi);
      #pragma unroll
      for(int d0=0;d0<2;++d0)stg[orow*64+d0*32+r32]=__float2bfloat16(o[d0][r]*rli[r]);}
    asm volatile("s_waitcnt lgkmcnt(0)":::"memory");
    #pragma unroll
    for(int i=0;i<4;++i){const int row=i*8+(lane>>3),ch=lane&7; const u32x4 v=*(const u32x4*)(stg+row*64+ch*8); ATTN_STORE16(Ow+(long)row*DM+ch*8,v);} }
  asm volatile("s_waitcnt lgkmcnt(0)\n\ts_barrier":::"memory");
  #undef KXMMA
  #undef DMA_K
  #undef DMA_V
  #undef CMASK
  #undef START
  #undef RESC
  #undef ROT
}
constexpr int ATTN_LDS_BYTES=LDS_BYTES;
struct AttnTensors { const bf16* Q; const bf16* K; const bf16* V; bf16* O; const float* LC; const float* TOT; };
struct AttnUnit { int bh; int qb; };
struct StaticOrder {
  int vcu;
  __device__ __forceinline__ explicit StaticOrder(int grid,int block):vcu((block%8)*(grid/8)+block/8){}
  __device__ __forceinline__ bool next(int i,AttnUnit&u)const{ if(i>=4)return false; const int s=2*(vcu&1)+(i>>1); u.bh=vcu>>1; u.qb=(i&1)?7-s:s; return true; }
  __device__ __forceinline__ void a_ready(const AttnUnit&)const{}
  __device__ __forceinline__ void done(const AttnUnit&)const{}
};
template<class Sched,int THRL=8> __device__ __forceinline__ void attn_phase(char*lds,const AttnTensors&T,const Sched&S){
  AttnUnit u;
  for(int i=0;S.next(i,u);++i){ S.a_ready(u); attn_unit<THRL>(u.bh/NHEAD,u.bh%NHEAD,u.qb,T.Q,T.K,T.V,T.O,T.LC,T.TOT,lds); S.done(u); }
}
#undef SBAR
#undef WAIT_BAR
}

constexpr int NWAVES = 8;
constexpr int CW_BAR = 4096;
constexpr int RING_OFF = 0, RING_BYTES = 131072;
constexpr int LDSCTL_OFF = RING_BYTES, MISC_OFF = LDSCTL_OFF + 320;
constexpr int LDS_BYTES = 147456;
#define GAS __attribute__((address_space(1)))
#define LAS __attribute__((address_space(3)))
typedef unsigned v4u __attribute__((ext_vector_type(4)));
#define LDS_WAIT() asm volatile("s_waitcnt lgkmcnt(0)" ::: "memory")
#define VM_WAIT() asm volatile("s_waitcnt vmcnt(0)" ::: "memory")
__device__ __forceinline__ unsigned pk2(float lo, float hi) { return f2bf(lo) | (f2bf(hi) << 16); }
#define XB_TMO      128
#define XB_XCNT(j)  (256  + 64 * (j))
#define XB_XSUB(j)  (1280 + 64 * (j))
#define XB_XGEN(j)  (2304 + 64 * (j))
#define XB_TOP      3328
#define XB_TOPGEN   3392
#define XCD_BAR_WORDS 3456
#define XB_SPIN_CAP (1u << 18)

__device__ __forceinline__ unsigned xb_ld(unsigned* p)              { return __hip_atomic_load(p, __ATOMIC_RELAXED, __HIP_MEMORY_SCOPE_AGENT); }
__device__ __forceinline__ unsigned xb_add(unsigned* p, unsigned v) { return __hip_atomic_fetch_add(p, v, __ATOMIC_RELAXED, __HIP_MEMORY_SCOPE_AGENT); }
__device__ __forceinline__ unsigned xb_xcc_id() { return (unsigned)__builtin_amdgcn_s_getreg((3 << 11) | 20) & 0xFu; }
#define XB_SPIN(cond, bar) do { unsigned _sp = 0; while (cond) { __builtin_amdgcn_s_sleep(1); \
    if ((++_sp & 255u) == 0u) { if (xb_ld(&(bar)[XB_TMO])) break; if (_sp > XB_SPIN_CAP) { atomicAdd(&(bar)[XB_TMO], 1u); break; } } } } while (0)

struct XcdBarrier {
    unsigned* bar; unsigned x;
    volatile LAS unsigned* st;
};

__device__ __forceinline__ XcdBarrier xcd_barrier_post(unsigned* bar, volatile LAS unsigned* st) {
    XcdBarrier b; b.bar = bar; b.x = xb_xcc_id(); b.st = st;
    if (threadIdx.x == 0) (void)xb_add(&bar[XB_XCNT(b.x)], 1u);
    return b;
}
__device__ __forceinline__ void xcd_barrier_complete(unsigned* bar, unsigned x, unsigned& nloc, unsigned& nx) {
    const unsigned G = gridDim.x * gridDim.y * gridDim.z;
    unsigned sum, cnt, mine, sp = 0u;
    for (;;) {
        sum = 0u; cnt = 0u; mine = 0u;
#pragma unroll
        for (unsigned j = 0; j < 16; ++j) { const unsigned c = xb_ld(&bar[XB_XCNT(j)]); sum += c; cnt += (c > 0u) ? 1u : 0u; mine = (j == x) ? c : mine; }
        if (sum == G) break;
        __builtin_amdgcn_s_sleep(1);
        if ((++sp & 255u) == 0u) { if (xb_ld(&bar[XB_TMO])) break; if (sp > XB_SPIN_CAP) { atomicAdd(&bar[XB_TMO], 1u); break; } }
    }
    nloc = mine > 0u ? mine : 1u; nx = cnt > 0u ? cnt : 1u;
}

__device__ __forceinline__ void xcd_barrier(const XcdBarrier& b) {
    asm volatile("s_waitcnt vmcnt(0)" ::: "memory");
    __syncthreads();
    if (threadIdx.x == 0) {
        unsigned* bar = b.bar;
        __builtin_amdgcn_s_waitcnt(0);
        unsigned nloc = b.st[0], nx = b.st[1];
        if (nloc == 0u) { xcd_barrier_complete(bar, b.x, nloc, nx); b.st[0] = nloc; b.st[1] = nx; }
        const unsigned old = xb_add(&bar[XB_XSUB(b.x)], 1u);
        const unsigned gen = old / nloc;
        if (old + 1u == (gen + 1u) * nloc) {
            __builtin_amdgcn_fence(__ATOMIC_RELEASE, "agent");
            asm volatile("s_waitcnt vmcnt(0)" ::: "memory");
            const unsigned og = xb_add(&bar[XB_TOP], 1u);
            const unsigned tg = og / nx;
            if (og + 1u == (tg + 1u) * nx) xb_add(&bar[XB_TOPGEN], 1u);
            else XB_SPIN(xb_ld(&bar[XB_TOPGEN]) == tg, bar);
            __builtin_amdgcn_fence(__ATOMIC_ACQUIRE, "agent");
            xb_add(&bar[XB_XGEN(b.x)], 1u);
            asm volatile("s_waitcnt vmcnt(0)" ::: "memory");
        } else {
            XB_SPIN(xb_ld(&bar[XB_XGEN(b.x)]) == gen, bar);
            __builtin_amdgcn_fence(__ATOMIC_ACQUIRE, "agent");
            asm volatile("s_waitcnt vmcnt(0)" ::: "memory");
        }
    }
    __syncthreads();
}

__device__ __forceinline__ void p0_transpose_item(const float* W, int ldw, int col, const float* gain, bf16_t* WT, int K, int rowbase, int k0, LAS float* scr, int lane) {
#pragma unroll 8
    for (int i = 0; i < 32; ++i) { const int kk = 2 * i + (lane >> 5); float v = W[(size_t)(k0 + kk) * ldw + col + (lane & 31)]; if (gain) v *= gain[k0 + kk]; scr[kk * 33 + (lane & 31)] = v; }
    LDS_WAIT(); asm volatile("" ::: "memory");
    const int c = lane & 7;
#pragma unroll
    for (int j = 0; j < 4; ++j) { const int n = (lane >> 3) + 8 * j; const LAS float* s = scr + (8 * c) * 33 + n;
        v4u o; o.x = pk2(s[0 * 33], s[1 * 33]); o.y = pk2(s[2 * 33], s[3 * 33]); o.z = pk2(s[4 * 33], s[5 * 33]); o.w = pk2(s[6 * 33], s[7 * 33]);
        *(GAS v4u*)(WT + (size_t)(rowbase + n) * K + k0 + 8 * c) = o; }
    LDS_WAIT(); asm volatile("" ::: "memory");
}
__device__ __forceinline__ bool p0_job(int& r, const float* W, int ldw, int coloff, int K, int N, const float* gain, bf16_t* WT, int rowoff, int il, int tile0, LAS float* scr, int lane) {
    const int nblk = N / 32, cnt = (K / 64) * nblk;
    if (r >= cnt) { r -= cnt; return false; }
    const int kb = r / nblk, nb = r % nblk, n0 = 32 * nb;
    const int rowbase = il < 0 ? rowoff + n0 : (tile0 + (n0 >> 7)) * 256 + il * 128 + (n0 & 127);
    p0_transpose_item(W, ldw, coloff + n0, gain, WT, K, rowbase, 64 * kb, scr, lane);
    return true;
}
__device__ __forceinline__ float wave_sum(float v) {
#pragma unroll
    for (int o = 1; o < 64; o <<= 1) v += __shfl_xor(v, o);
    return v;
}

struct Args { const float* in[17]; float* out; unsigned char* ws; int ph_lo, ph_hi; };
constexpr int N_PHASES = 10;

__global__ void __launch_bounds__(NWAVES * 64, 2) mk_fwd(Args args) {
    extern __shared__ __attribute__((aligned(16))) unsigned char lds[];
    LAS unsigned char* ldsp = (LAS unsigned char*)lds;
    volatile LAS unsigned* MISC = (volatile LAS unsigned*)(ldsp + MISC_OFF);
    const int tid = threadIdx.x, lane = tid & 63, wave = __builtin_amdgcn_readfirstlane(tid >> 6);
    const int G = gridDim.x; const int bx = blockIdx.x; const int vcu = (G % 8 == 0) ? (bx % 8) * (G / 8) + bx / 8 : bx;
    const int gw = vcu * NWAVES + wave, NGW = G * NWAVES;
    unsigned char* const ws = args.ws;
#define XIN0 (args.in[0])
#define OUTP (args.out)
#define SSQ ((float*)(ws + WS_SSQ))
#define LC ((float*)(ws + WS_LC))
#define TOT ((float*)(ws + WS_TOT))
#define WF ((float*)(ws + WS_WF))
#define W1GU ((bf16_t*)(ws + WS_W1GU))
#define W1D ((bf16_t*)(ws + WS_W1D))
#define WIN ((bf16_t*)(ws + WS_WIN))
#define WOA ((bf16_t*)(ws + WS_WOA))
#define WOC ((bf16_t*)(ws + WS_WOC))
#define WOUT ((bf16_t*)(ws + WS_WOUT))
#define W2GU ((bf16_t*)(ws + WS_W2GU))
#define W2D ((bf16_t*)(ws + WS_W2D))
#define XN ((bf16_t*)(ws + WS_XN))
#define Qb ((bf16_t*)(ws + WS_Q))
#define Kb ((bf16_t*)(ws + WS_K))
#define Vb ((bf16_t*)(ws + WS_V))
#define Ub ((bf16_t*)(ws + WS_U))
#define CBb ((bf16_t*)(ws + WS_CB))
#define YCV ((bf16_t*)(ws + WS_YCV))
#define Hb ((bf16_t*)(ws + WS_H))
#define GAb ((bf16_t*)(ws + WS_GA))
#define GCb ((bf16_t*)(ws + WS_GC))
#define Tb ((bf16_t*)(ws + WS_T))
    for (int u = tid; u < (LDS_BYTES - LDSCTL_OFF) / 4; u += NWAVES * 64) ((LAS unsigned*)(ldsp + LDSCTL_OFF))[u] = 0u;
    __syncthreads();
    const int lo = args.ph_lo, hi = args.ph_hi;
    const bool multi = (hi - lo) > 1;
    XcdBarrier bar; bar.bar = (unsigned*)(ws + WS_CTL) + CW_BAR; bar.x = 0; bar.st = nullptr;
    if (multi) bar = xcd_barrier_post((unsigned*)(ws + WS_CTL) + CW_BAR, MISC + 8);
#ifndef PHASE_MASK
#define PHASE_MASK 0x3ff
#endif
#define IN(k) (((PHASE_MASK >> (k)) & 1) && lo <= (k) && (k) < hi)
#define SEAM(k) do { if (IN(k) && IN((k) + 1)) xcd_barrier(bar); } while (0)

    if (IN(0)) {
        LAS float* scr = (LAS float*)(ldsp + RING_OFF + wave * 16384);
        const float *n1 = args.in[1], *nm = args.in[5], *n2 = args.in[12], *win = args.in[6];
        constexpr int NITEMS = 2 * (2 * 1408 + 1408) + 768 + 3 * 256 + 2 * 512 + 2 * 256 + 512;
        for (int it = gw; it < NITEMS; it += NGW) {
            int r = it;
            if (p0_job(r, args.in[2], FF, 0, DM, FF, n1, W1GU, 0, 0, 0, scr, lane)) continue;
            if (p0_job(r, args.in[3], FF, 0, DM, FF, n1, W1GU, 0, 1, 0, scr, lane)) continue;
            if (p0_job(r, args.in[4], DM, 0, FF, DM, nullptr, W1D, 0, -1, 0, scr, lane)) continue;
            if (p0_job(r, win, INC, IC_Q, DM, 1536, nm, WIN, 0, -1, 0, scr, lane)) continue;
            if (p0_job(r, win, INC, IC_CB, DM, 512, nm, WIN, 2560, -1, 0, scr, lane)) continue;
            if (p0_job(r, win, INC, IC_CC, DM, 512, nm, WIN, 0, 0, 6, scr, lane)) continue;
            if (p0_job(r, win, INC, IC_CX, DM, 512, nm, WIN, 0, 1, 6, scr, lane)) continue;
            if (p0_job(r, win, INC, IC_GA, DM, 1024, nm, WIN, 3072, -1, 0, scr, lane)) continue;
            if (p0_job(r, win, INC, IC_GC, DM, 1024, nm, WIN, 4096, -1, 0, scr, lane)) continue;
            if (p0_job(r, args.in[9], DM, 0, AW, DM, nullptr, WOA, 0, -1, 0, scr, lane)) continue;
            if (p0_job(r, args.in[10], DM, 0, CW, DM, nullptr, WOC, 0, -1, 0, scr, lane)) continue;
            if (p0_job(r, args.in[11], DM, 0, DM, DM, nullptr, WOUT, 0, -1, 0, scr, lane)) continue;
            if (p0_job(r, args.in[13], FF, 0, DM, FF, n2, W2GU, 0, 0, 0, scr, lane)) continue;
            if (p0_job(r, args.in[14], FF, 0, DM, FF, n2, W2GU, 0, 1, 0, scr, lane)) continue;
            p0_job(r, args.in[15], DM, 0, FF, DM, nullptr, W2D, 0, -1, 0, scr, lane);
        }
        for (int i = gw * 64 + lane; i < NH * DM; i += NGW * 64) { const int h = i >> 10, k = i & 1023; WF[i] = win[(size_t)k * INC + IC_F + h] * nm[k]; }
        for (int m = gw; m < M; m += NGW) {
            const GAS f32x4* xr = (const GAS f32x4*)(XIN0 + (size_t)m * DM) + lane; f32x4 v[4]; float s = 0.f;
#pragma unroll
            for (int j = 0; j < 4; ++j) { v[j] = xr[64 * j]; s += (v[j].x * v[j].x + v[j].y * v[j].y) + (v[j].z * v[j].z + v[j].w * v[j].w); }
            s = wave_sum(s);
            GAS unsigned long long* o8 = (GAS unsigned long long*)(XN + (size_t)m * DM) + lane;
#pragma unroll
            for (int j = 0; j < 4; ++j) o8[64 * j] = (unsigned long long)pk2(v[j].x, v[j].y) | ((unsigned long long)pk2(v[j].z, v[j].w) << 32);
            if (lane < 16) SSQ[(size_t)m * 16 + lane] = lane == 0 ? s : 0.f;
        }
    }
    SEAM(0);
    if (IN(1)) {
        pg8::Gemm g{XN, W1GU, M, NGU, DM}; pg8::StaticOrder S; S.init(M, NGU, G, bx);
        pg8::EpiSwiglu E{Hb, SSQ};
        pg8::gemm_phase<pg8::EpiSwiglu, pg8::StaticOrder, PG8_ALIGN, PG8_SP2>(ldsp + RING_OFF, g, S, E);
    }
    SEAM(1);
    if (IN(2)) {
        pg8::Gemm g{Hb, W1D, M, DM, FF}; pg8::StaticOrder S; S.init(M, DM, G, bx);
        pg8::EpiResid E{XIN0, OUTP, XN, SSQ, 0.5f, 0};
        pg8::gemm_phase<pg8::EpiResid, pg8::StaticOrder, PG8_ALIGN, PG8_SP2>(ldsp + RING_OFF, g, S, E);
    }
    SEAM(2);
    if (IN(3)) {
        const float* bfg = args.in[7];
        LAS float* lf = (LAS float*)(ldsp + RING_OFF);
        for (int un = vcu; un < NB * NCHUNK; un += G) {
            const int b = un / NCHUNK, ch = un % NCHUNK; const int rbase = b * SEQ + ch * CHUNK + wave * 16;
            float w[NH][16];
#pragma unroll
            for (int h = 0; h < NH; ++h) { const f32x4 a0 = *(const f32x4*)(WF + h * DM + 8 * lane), a1 = *(const f32x4*)(WF + h * DM + 8 * lane + 4), a2 = *(const f32x4*)(WF + h * DM + 512 + 8 * lane), a3 = *(const f32x4*)(WF + h * DM + 512 + 8 * lane + 4);
#pragma unroll
                for (int e = 0; e < 4; ++e) { w[h][e] = a0[e]; w[h][4 + e] = a1[e]; w[h][8 + e] = a2[e]; w[h][12 + e] = a3[e]; } }
            for (int i = 0; i < 16; ++i) {
                const int r = rbase + i;
                f32x4 xa, xb, xc, xd; pg8::unpack8(*(const pg8::u32x4*)(XN + (size_t)r * DM + 8 * lane), xa, xb); pg8::unpack8(*(const pg8::u32x4*)(XN + (size_t)r * DM + 512 + 8 * lane), xc, xd);
                float acc[NH];
#pragma unroll
                for (int h = 0; h < NH; ++h) { float a = 0.f;
#pragma unroll
                    for (int e = 0; e < 4; ++e) { a += xa[e] * w[h][e]; a += xb[e] * w[h][4 + e]; a += xc[e] * w[h][8 + e]; a += xd[e] * w[h][12 + e]; }
                    acc[h] = wave_sum(a); }
                float a = acc[0];
#pragma unroll
                for (int h = 1; h < NH; ++h) a = (lane == h) ? acc[h] : a;
                if (lane < NH) { const float z = a * pg8::rstd_of(SSQ, r) + bfg[lane]; const float ls = fminf(z, 0.f) - log1pf(__expf(-fabsf(z))); lf[(wave * 16 + i) * NH + lane] = ls * LOG2E; }
            }
            LDS_WAIT(); __syncthreads();
            {
                const int h = wave; const float v0 = lf[(2 * lane) * NH + h], v1 = lf[(2 * lane + 1) * NH + h], b2 = v0 + v1; float inc = b2;
#pragma unroll
                for (int o = 1; o < 64; o <<= 1) { const float t = __shfl_up(inc, o); if (lane >= o) inc += t; }
                const float exc = inc - b2;
                float* dst = LC + ((size_t)b * NH + h) * SEQ + ch * CHUNK + 2 * lane; dst[0] = exc + v0; dst[1] = exc + b2;
                if (lane == 63) TOT[((size_t)b * NCHUNK + ch) * NH + h] = inc;
            }
            LDS_WAIT(); __syncthreads();
        }
        pg8::Gemm g{XN, WIN, M, NWIN, DM}; pg8::StaticOrder S; S.init(M, NWIN, G, bx);
        pg8::EpiWin E{Qb, Kb, Vb, Ub, CBb, GAb, GCb, SSQ};
        pg8::gemm_phase<pg8::EpiWin, pg8::StaticOrder, PG8_ALIGN, PG8_SP2>(ldsp + RING_OFF, g, S, E);
    }
    SEAM(3);
    if (IN(4)) {
        const attn_body::AttnTensors AT{(const attn_body::bf16*)Qb, (const attn_body::bf16*)Kb, (const attn_body::bf16*)Vb, (attn_body::bf16*)Qb, LC, TOT};
        const attn_body::StaticOrder S(G, bx);
        attn_body::attn_phase<attn_body::StaticOrder>((char*)lds + RING_OFF, AT, S);
        const float* cwp = args.in[8];
        float cw0[8], cw1[8], cw2[8];
#pragma unroll
        for (int e = 0; e < 8; ++e) { cw0[e] = cwp[8 * lane + e]; cw1[e] = cwp[CW + 8 * lane + e]; cw2[e] = cwp[2 * CW + 8 * lane + e]; }
        for (int blk = gw; blk < M / 16; blk += NGW) {
            const int R0 = blk * 16; const bool first = (R0 % SEQ) == 0;
            f32x4 ua0 = {0.f, 0.f, 0.f, 0.f}, ub0 = ua0, ua1 = ua0, ub1 = ua0;
            if (!first) { pg8::unpack8(*(const pg8::u32x4*)(Ub + (size_t)(R0 - 2) * CW + 8 * lane), ua0, ub0); pg8::unpack8(*(const pg8::u32x4*)(Ub + (size_t)(R0 - 1) * CW + 8 * lane), ua1, ub1); }
#pragma unroll 4
            for (int i = 0; i < 16; ++i) {
                const size_t off = (size_t)(R0 + i) * CW + 8 * lane;
                f32x4 ua2, ub2, ca, cb; pg8::unpack8(*(const pg8::u32x4*)(Ub + off), ua2, ub2); pg8::unpack8(*(const pg8::u32x4*)(CBb + off), ca, cb);
                f32x4 ya, yb;
#pragma unroll
                for (int e = 0; e < 4; ++e) { ya[e] = ca[e] * (cw0[e] * ua0[e] + cw1[e] * ua1[e] + cw2[e] * ua2[e]); yb[e] = cb[e] * (cw0[4 + e] * ub0[e] + cw1[4 + e] * ub1[e] + cw2[4 + e] * ub2[e]); }
                *(pg8::u32x4*)(YCV + off) = pg8::pack8(ya, yb);
                ua0 = ua1; ub0 = ub1; ua1 = ua2; ub1 = ub2;
            }
        }
    }
    SEAM(4);
    if (IN(5)) {
        { pg8::Gemm g{Qb, WOA, M, DM, AW}; pg8::StaticOrder S; S.init(M, DM, G, bx); pg8::EpiGate<0> E{GAb, Tb};
          pg8::gemm_phase<pg8::EpiGate<0>, pg8::StaticOrder, PG8_ALIGN, PG8_SP2>(ldsp + RING_OFF, g, S, E); }
        { pg8::Gemm g{YCV, WOC, M, DM, CW}; pg8::StaticOrder S; S.init(M, DM, G, bx); pg8::EpiGate<1> E{GCb, Tb};
          pg8::gemm_phase<pg8::EpiGate<1>, pg8::StaticOrder, PG8_ALIGN, PG8_SP2>(ldsp + RING_OFF, g, S, E); }
    }
    SEAM(5);
    if (IN(6)) {
        pg8::Gemm g{Tb, WOUT, M, DM, DM}; pg8::StaticOrder S; S.init(M, DM, G, bx);
        pg8::EpiResid E{OUTP, OUTP, XN, SSQ, 1.0f, 0};
        pg8::gemm_phase<pg8::EpiResid, pg8::StaticOrder, PG8_ALIGN, PG8_SP2>(ldsp + RING_OFF, g, S, E);
    }
    SEAM(6);
    if (IN(7)) {
        pg8::Gemm g{XN, W2GU, M, NGU, DM}; pg8::StaticOrder S; S.init(M, NGU, G, bx);
        pg8::EpiSwiglu E{Hb, SSQ};
        pg8::gemm_phase<pg8::EpiSwiglu, pg8::StaticOrder, PG8_ALIGN, PG8_SP2>(ldsp + RING_OFF, g, S, E);
    }
    SEAM(7);
    if (IN(8)) {
        pg8::Gemm g{Hb, W2D, M, DM, FF}; pg8::StaticOrder S; S.init(M, DM, G, bx);
        pg8::EpiResid E{OUTP, OUTP, XN, SSQ, 0.5f, 0};
        pg8::gemm_phase<pg8::EpiResid, pg8::StaticOrder, PG8_ALIGN, PG8_SP2>(ldsp + RING_OFF, g, S, E);
    }
    SEAM(8);
    if (IN(9)) {
        const float* gf = args.in[16]; f32x4 gv[4];
#pragma unroll
        for (int j = 0; j < 4; ++j) gv[j] = *((const f32x4*)gf + lane + 64 * j);
        for (int m = gw; m < M; m += NGW) {
            const float rs = pg8::rstd_of(SSQ, m);
            GAS f32x4* xr = (GAS f32x4*)(OUTP + (size_t)m * DM) + lane;
#pragma unroll
            for (int j = 0; j < 4; ++j) { const f32x4 v = xr[64 * j]; xr[64 * j] = v * rs * gv[j]; }
        }
    }
#undef IN
#undef SEAM
#undef XIN0
#undef OUTP
#undef SSQ
#undef LC
#undef TOT
#undef WF
#undef W1GU
#undef W1D
#undef WIN
#undef WOA
#undef WOC
#undef WOUT
#undef W2GU
#undef W2D
#undef XN
#undef Qb
#undef Kb
#undef Vb
#undef Ub
#undef CBb
#undef YCV
#undef Hb
#undef GAb
#undef GCb
#undef Tb
}

#ifndef FAST_MASK
#define FAST_MASK 0x3ff
#endif
#ifndef ONE_LAUNCH
#define ONE_LAUNCH 0
#endif
extern "C" void kernel_launch(void* const* d_in, const int* in_sizes, int n_in, void* d_out, int out_size, void* d_ws, size_t ws_size, hipStream_t stream) {
    static int grid = 0;
    if (grid == 0) {
        if (n_in != 17 || in_sizes[0] != M * DM || out_size != M * DM || ws_size < WS_END) { fprintf(stderr, "kernel_launch: unexpected shapes (n_in %d in0 %d out %d ws %zu)\n", n_in, n_in > 0 ? in_sizes[0] : -1, out_size, ws_size); grid = -1; return; }
        int dev = 0, cus = 0;
        if (hipGetDevice(&dev) != hipSuccess || hipDeviceGetAttribute(&cus, hipDeviceAttributeMultiprocessorCount, dev) != hipSuccess) { fprintf(stderr, "kernel_launch: device query failed\n"); grid = -1; return; }
        if (hipFuncSetAttribute((const void*)mk_fwd, hipFuncAttributeMaxDynamicSharedMemorySize, LDS_BYTES) != hipSuccess) { fprintf(stderr, "kernel_launch: hipFuncSetAttribute failed\n"); grid = -1; return; }
        (void)hipGetLastError();
        grid = cus;
    }
    if (grid < 0) return;
    const float* x = (const float*)d_in[0];
    const float *n1 = (const float*)d_in[1], *w1g = (const float*)d_in[2], *w1u = (const float*)d_in[3], *w1d = (const float*)d_in[4], *nm = (const float*)d_in[5], *win = (const float*)d_in[6];
    const float *bfg = (const float*)d_in[7], *cw = (const float*)d_in[8], *woa = (const float*)d_in[9], *woc = (const float*)d_in[10], *wout = (const float*)d_in[11];
    const float *n2 = (const float*)d_in[12], *w2g = (const float*)d_in[13], *w2u = (const float*)d_in[14], *w2d = (const float*)d_in[15], *nf = (const float*)d_in[16];
    float* out = (float*)d_out; unsigned char* ws = (unsigned char*)d_ws;
    float* SSQ = (float*)(ws + WS_SSQ); float* LC = (float*)(ws + WS_LC); float* TOT = (float*)(ws + WS_TOT); float* WF = (float*)(ws + WS_WF);
    bf16_t *W1GU = (bf16_t*)(ws + WS_W1GU), *W1D = (bf16_t*)(ws + WS_W1D), *WIN = (bf16_t*)(ws + WS_WIN), *WOA = (bf16_t*)(ws + WS_WOA), *WOC = (bf16_t*)(ws + WS_WOC), *WOUT = (bf16_t*)(ws + WS_WOUT), *W2GU = (bf16_t*)(ws + WS_W2GU), *W2D = (bf16_t*)(ws + WS_W2D);
    bf16_t *XN = (bf16_t*)(ws + WS_XN), *Q = (bf16_t*)(ws + WS_Q), *Kb = (bf16_t*)(ws + WS_K), *Vb = (bf16_t*)(ws + WS_V), *U = (bf16_t*)(ws + WS_U), *CB = (bf16_t*)(ws + WS_CB), *YCV = (bf16_t*)(ws + WS_YCV);
    bf16_t *H = (bf16_t*)(ws + WS_H), *GA = (bf16_t*)(ws + WS_GA), *GC = (bf16_t*)(ws + WS_GC), *T = (bf16_t*)(ws + WS_T);
    Args a{};
    for (int i = 0; i < 17; ++i) a.in[i] = (const float*)d_in[i];
    a.out = out; a.ws = ws;
    if (hipMemsetAsync(ws + WS_CTL, 0, 1 * MiB, stream) != hipSuccess) { fprintf(stderr, "kernel_launch: memset failed\n"); return; }
    auto fast = [&](int lo, int hi) { a.ph_lo = lo; a.ph_hi = hi; hipLaunchKernelGGL(mk_fwd, dim3(grid), dim3(NWAVES * 64), LDS_BYTES, stream, a); };
    if (ONE_LAUNCH && (FAST_MASK & 0x3ff) == 0x3ff) { fast(0, N_PHASES); return; }
    auto cvt = [&](const float* W, int K, int N, bf16_t* Bt, const float* gain, int mode) { const long n = (long)K * N; nv_convert_w<<<(unsigned)((n + 255) / 256), 256, 0, stream>>>(W, Bt, gain, WF, K, N, mode, 0); };
    for (int p = 0; p < N_PHASES; ++p) {
        if ((FAST_MASK >> p) & 1) { fast(p, p + 1); continue; }
        switch (p) {
        case 0:
            cvt(w1g, DM, FF, W1GU, n1, 1); cvt(w1u, DM, FF, W1GU, n1, 2); cvt(w1d, FF, DM, W1D, nullptr, 0);
            cvt(win, DM, INC, WIN, nm, 3); cvt(woa, AW, DM, WOA, nullptr, 0); cvt(woc, CW, DM, WOC, nullptr, 0); cvt(wout, DM, DM, WOUT, nullptr, 0);
            cvt(w2g, DM, FF, W2GU, n2, 1); cvt(w2u, DM, FF, W2GU, n2, 2); cvt(w2d, FF, DM, W2D, nullptr, 0);
            nv_x_to_xn<<<M / 4, 256, 0, stream>>>(x, XN, SSQ); break;
        case 1: nv_gemm<NvSwiglu><<<dim3(NGU / 128, M / 64), 256, 0, stream>>>(XN, W1GU, SSQ, NGU, DM, 1, 0, NvSwiglu{H}); break;
        case 2: nv_gemm<NvResid><<<dim3(DM / 64, M / 64), 256, 0, stream>>>(H, W1D, nullptr, DM, FF, 0, 0, NvResid{x, out, XN, 0.5f, 0}); nv_rowstats<<<M / 4, 256, 0, stream>>>(out, SSQ); break;
        case 3:
            nv_flogit<<<M / 4, 256, 0, stream>>>(XN, WF, SSQ, bfg, LC); nv_scan<<<(NB * NH * NCHUNK + 255) / 256, 256, 0, stream>>>(LC, TOT);
            nv_gemm<NvWin><<<dim3(NWIN / 64, M / 64), 256, 0, stream>>>(XN, WIN, SSQ, NWIN, DM, 2, 0, NvWin{Q, Kb, Vb, U, CB, GA, GC}); break;
        case 4: nv_attn<<<NB * NH * SEQ, 64, 0, stream>>>(Q, Kb, Vb, Q, LC, TOT); nv_conv<<<(unsigned)(((long)M * CW + 255) / 256), 256, 0, stream>>>(U, CB, cw, YCV); break;
        case 5:
            nv_gemm<NvGateA><<<dim3(DM / 64, M / 64), 256, 0, stream>>>(Q, WOA, nullptr, DM, AW, 0, 0, NvGateA{GA, T});
            nv_gemm<NvGateC><<<dim3(DM / 64, M / 64), 256, 0, stream>>>(YCV, WOC, nullptr, DM, CW, 0, 0, NvGateC{GC, T}); break;
        case 6: nv_gemm<NvResid><<<dim3(DM / 64, M / 64), 256, 0, stream>>>(T, WOUT, nullptr, DM, DM, 0, 0, NvResid{out, out, XN, 1.0f, 0}); nv_rowstats<<<M / 4, 256, 0, stream>>>(out, SSQ); break;
        case 7: nv_gemm<NvSwiglu><<<dim3(NGU / 128, M / 64), 256, 0, stream>>>(XN, W2GU, SSQ, NGU, DM, 1, 0, NvSwiglu{H}); break;
        case 8: nv_gemm<NvResid><<<dim3(DM / 64, M / 64), 256, 0, stream>>>(H, W2D, nullptr, DM, FF, 0, 0, NvResid{out, out, XN, 0.5f, 0}); nv_rowstats<<<M / 4, 256, 0, stream>>>(out, SSQ); break;
        case 9: nv_final<<<M / 4, 256, 0, stream>>>(out, SSQ, nf, out); break;
        }
    }
}
```
